# Optimizing an MI355X kernel written in HIP

```python
import math
import jax, jax.numpy as jnp
from jax import lax
import numpy as np

D_MODEL = 1024
BATCH = 1
SEQ = 16384
DEPTH = 4

GRID_W = 64
CTX_LEN = 256
N_MIXERS = 3
BLOCK = 128
ROPE_BASE = 10000.0
RMS_EPS = 1e-6
N_MOD = 6

A_HEADS = 8
A_KV_HEADS = 2
A_GROUP = A_HEADS // A_KV_HEADS
A_HEAD_DIM = D_MODEL // A_HEADS
A_WINDOW = 128
A_SCALE = A_HEAD_DIM ** -0.5
A_QKV = (A_HEADS + 2 * A_KV_HEADS) * A_HEAD_DIM

B_WIDTH = D_MODEL
B_BLOCKS = 4
B_BLOCK_W = B_WIDTH // B_BLOCKS
B_CONV_W = 4
B_CONV_PAD_L = (B_CONV_W - 1) // 2
B_LRU_C = 8.0

C_HEADS = 8
C_NOPE = 128
C_ROPE = 64
C_VDIM = 128
C_Q_RANK = D_MODEL // 2
C_KV_RANK = D_MODEL // 4
C_SCALE = (C_NOPE + C_ROPE) ** -0.5
C_IN = C_Q_RANK + C_KV_RANK + C_ROPE

FFN_HIDDEN = ((8 * D_MODEL + 3 * 256 - 1) // (3 * 256)) * 256

kernel_name = 'hybrid_dit_swa_rglru_mla_interleaved'


def rms_norm(x, g):
    xf = x.astype(jnp.float32)
    y = xf * lax.rsqrt(jnp.mean(xf * xf, axis=-1, keepdims=True) + RMS_EPS)
    return (y * g.astype(jnp.float32)).astype(x.dtype)


def modulate(h, shift, scale):
    return h * (1 + scale) + shift


def axial_rope_tables(n_tokens, d_rot):
    n_rows = n_tokens // GRID_W
    row = jnp.repeat(jnp.arange(n_rows), GRID_W).astype(jnp.float32)
    col = jnp.tile(jnp.arange(GRID_W), n_rows).astype(jnp.float32)
    d_axis = d_rot // 2
    inv = 1.0 / (ROPE_BASE ** (jnp.arange(0, d_axis, 2, dtype=jnp.float32) / d_axis))
    ang = jnp.stack([row[:, None] * inv, col[:, None] * inv], axis=1)
    return jnp.cos(ang), jnp.sin(ang)


def apply_axial_rope(x, cos, sin):
    shp = x.shape
    xf = x.astype(jnp.float32).reshape(shp[:-1] + (2, 2, shp[-1] // 4))
    x1 = xf[..., 0, :]
    x2 = xf[..., 1, :]
    c = cos[None, :, None]
    s = sin[None, :, None]
    out = jnp.stack([x1 * c - x2 * s, x2 * c + x1 * s], axis=-2)
    return out.reshape(shp).astype(x.dtype)


def swiglu(h, w_gu, w_down):
    z = h @ w_gu
    return (jax.nn.silu(z[..., :FFN_HIDDEN]) * z[..., FFN_HIDDEN:]) @ w_down


def windowed_gqa(h, hc, w_qkv, sinks, w_o, cos, sin, need_ctx):
    B, T, _ = h.shape
    nb = T // BLOCK
    q_w = A_HEADS * A_HEAD_DIM
    kv_w = A_KV_HEADS * A_HEAD_DIM

    def project(u):
        L = u.shape[1]
        z = u @ w_qkv
        q = z[..., :q_w].reshape(B, L, A_HEADS, A_HEAD_DIM)
        k = z[..., q_w:q_w + kv_w].reshape(B, L, A_KV_HEADS, A_HEAD_DIM)
        v = z[..., q_w + kv_w:].reshape(B, L, A_KV_HEADS, A_HEAD_DIM)
        return q, k, v

    q, k, v = project(h)
    q = apply_axial_rope(q, cos, sin)
    k = apply_axial_rope(k, cos, sin)
    qc, kc, vc = project(hc)
    n_ctx = kc.shape[1]
    sink = sinks.astype(jnp.float32).reshape(A_KV_HEADS, A_GROUP)

    qb = q.reshape(B, nb, BLOCK, A_KV_HEADS, A_GROUP, A_HEAD_DIM)

    def band(t):
        tp = jnp.pad(t, ((0, 0), (BLOCK, BLOCK), (0, 0), (0, 0))).reshape(B, nb + 2, BLOCK, A_KV_HEADS, A_HEAD_DIM)
        return jnp.concatenate([tp[:, :-2], tp[:, 1:-1], tp[:, 2:]], axis=2)

    kw = band(k)
    vw = band(v)
    blk = jnp.arange(nb)[:, None, None]
    qpos = blk * BLOCK + jnp.arange(BLOCK)[None, :, None]
    kpos = (blk - 1) * BLOCK + jnp.arange(3 * BLOCK)[None, None, :]
    valid = (jnp.abs(kpos - qpos) <= A_WINDOW) & (kpos >= 0) & (kpos < T)
    s_win = jnp.einsum('bnqkgd,bnjkd->bnkgqj', qb, kw).astype(jnp.float32) * A_SCALE
    s_win = jnp.where(valid[None, :, None, None], s_win, -jnp.inf)
    s_ctx = jnp.einsum('bnqkgd,bckd->bnkgqc', qb, kc).astype(jnp.float32) * A_SCALE
    s_sink = jnp.broadcast_to(sink[None, None, :, :, None, None], s_ctx.shape[:-1] + (1,))
    p = jax.nn.softmax(jnp.concatenate([s_sink, s_ctx, s_win], axis=-1), axis=-1).astype(v.dtype)
    o = (jnp.einsum('bnkgqc,bckd->bnqkgd', p[..., 1:1 + n_ctx], vc)
         + jnp.einsum('bnkgqj,bnjkd->bnqkgd', p[..., 1 + n_ctx:], vw))
    y = o.reshape(B, T, q_w) @ w_o

    if need_ctx:
        qcg = qc.reshape(B, n_ctx, A_KV_HEADS, A_GROUP, A_HEAD_DIM)
        sc = jnp.einsum('bqkgd,bckd->bkgqc', qcg, kc).astype(jnp.float32) * A_SCALE
        ss = jnp.broadcast_to(sink[None, :, :, None, None], sc.shape[:-1] + (1,))
        pc = jax.nn.softmax(jnp.concatenate([ss, sc], axis=-1), axis=-1)[..., 1:].astype(vc.dtype)
        yc = jnp.einsum('bkgqc,bckd->bqkgd', pc, vc).reshape(B, n_ctx, q_w) @ w_o
    else:
        yc = None
    return y, yc


def centred_depthwise_conv(u, w, b):
    T = u.shape[1]
    up = jnp.pad(u, ((0, 0), (B_CONV_PAD_L, B_CONV_W - 1 - B_CONV_PAD_L), (0, 0)))
    return b + sum(w[k] * up[:, k:k + T] for k in range(B_CONV_W))


def block_diag(u, w):
    ub = u.reshape(u.shape[0], u.shape[1], B_BLOCKS, B_BLOCK_W)
    return jnp.einsum('btnk,nkj->btnj', ub, w).reshape(u.shape)


def rglru_coeffs(u, lam, w_a, b_a, w_x, b_x):
    uf = u.astype(jnp.float32)
    r = jax.nn.sigmoid(block_diag(uf, w_a.astype(jnp.float32)) + b_a.astype(jnp.float32))
    i = jax.nn.sigmoid(block_diag(uf, w_x.astype(jnp.float32)) + b_x.astype(jnp.float32))
    log_a = -B_LRU_C * r * jax.nn.softplus(-lam.astype(jnp.float32))
    a = jnp.exp(log_a)
    b = jnp.sqrt(-jnp.expm1(2.0 * log_a)) * (i * uf)
    return a, b


def linear_scan(a, b, h0, reverse):
    if reverse:
        a = jnp.flip(a, 1)
        b = jnp.flip(b, 1)

    def combine(l, r):
        return (l[0] * r[0], r[0] * l[1] + r[1])

    acc_a, acc_b = lax.associative_scan(combine, (a, b), axis=1)
    h = acc_a * h0[:, None, :] + acc_b
    return jnp.flip(h, 1) if reverse else h


def rglru_block(h, hc, w_in, conv_w, conv_b, lam, w_a, b_a, w_x, b_x, w_out, need_ctx):
    B = h.shape[0]

    def branches(u):
        z = u @ w_in
        return centred_depthwise_conv(z[..., :B_WIDTH], conv_w, conv_b), jax.nn.gelu(z[..., B_WIDTH:])

    xb, gate = branches(h)
    xbc, gatec = branches(hc)
    h_sum = 0.0
    hc_sum = 0.0
    for d, reverse in enumerate((False, True)):
        a_c, b_c = rglru_coeffs(xbc, lam[d], w_a[d], b_a[d], w_x[d], b_x[d])
        hs_c = linear_scan(a_c, b_c, jnp.zeros((B, B_WIDTH), jnp.float32), reverse)
        h0 = hs_c[:, 0] if reverse else hs_c[:, -1]
        a_l, b_l = rglru_coeffs(xb, lam[d], w_a[d], b_a[d], w_x[d], b_x[d])
        h_sum = h_sum + linear_scan(a_l, b_l, h0, reverse)
        if need_ctx:
            hc_sum = hc_sum + hs_c
    y = (h_sum.astype(h.dtype) * gate) @ w_out
    yc = (hc_sum.astype(h.dtype) * gatec) @ w_out if need_ctx else None
    return y, yc


def mla(h, hc, w_in, g_q, g_kv, w_uq, w_ukv, w_out, cos, sin, need_ctx):
    B, T, _ = h.shape
    w_ukv3 = w_ukv.reshape(C_KV_RANK, C_HEADS, C_NOPE + C_VDIM)
    w_uk = w_ukv3[..., :C_NOPE]
    w_uv = w_ukv3[..., C_NOPE:]

    def project(u, rotate):
        L = u.shape[1]
        z = u @ w_in
        cq = rms_norm(z[..., :C_Q_RANK], g_q)
        ckv = rms_norm(z[..., C_Q_RANK:C_Q_RANK + C_KV_RANK], g_kv)
        kr = z[..., C_Q_RANK + C_KV_RANK:].reshape(B, L, 1, C_ROPE)
        q = (cq @ w_uq).reshape(B, L, C_HEADS, C_NOPE + C_ROPE)
        qn, qr = q[..., :C_NOPE], q[..., C_NOPE:]
        if rotate:
            qr = apply_axial_rope(qr, cos, sin)
            kr = apply_axial_rope(kr, cos, sin)
        kn = jnp.einsum('blc,chn->blhn', ckv, w_uk)
        v = jnp.einsum('blc,chv->blhv', ckv, w_uv)
        return qn, qr, kn, kr[:, :, 0], v

    qn, qr, kn, kr, v = project(h, True)
    qnc, qrc, knc, krc, vc = project(hc, False)
    kn_all = jnp.concatenate([knc, kn], axis=1)
    kr_all = jnp.concatenate([krc, kr], axis=1)
    v_all = jnp.concatenate([vc, v], axis=1)

    def attend(qn_b, qr_b, kn_, kr_, v_):
        s = (jnp.einsum('bqhn,bkhn->bhqk', qn_b, kn_)
             + jnp.einsum('bqhr,bkr->bhqk', qr_b, kr_)).astype(jnp.float32) * C_SCALE
        p = jax.nn.softmax(s, axis=-1).astype(v_.dtype)
        return jnp.einsum('bhqk,bkhv->bqhv', p, v_)

    nb = T // BLOCK

    def to_blocks(t):
        return jnp.moveaxis(t.reshape((B, nb, BLOCK) + t.shape[2:]), 1, 0)

    o = lax.map(lambda qs: attend(qs[0], qs[1], kn_all, kr_all, v_all), (to_blocks(qn), to_blocks(qr)))
    o = jnp.moveaxis(o, 0, 1).reshape(B, T, C_HEADS * C_VDIM)
    y = o @ w_out
    if need_ctx:
        yc = attend(qnc, qrc, knc, krc, vc).reshape(B, qnc.shape[1], C_HEADS * C_VDIM) @ w_out
    else:
        yc = None
    return y, yc


def setup_inputs(seed: int = 0) -> dict:
    key = jax.random.key(seed)
    ks = iter(jax.random.split(key, 40))
    f32 = jnp.float32
    n_a = (DEPTH + N_MIXERS - 1) // N_MIXERS
    n_b = (DEPTH + N_MIXERS - 2) // N_MIXERS
    n_c = DEPTH // N_MIXERS

    def nrm(shape, fan_in, gain=1.0):
        return gain * fan_in ** -0.5 * jax.random.normal(next(ks), shape, f32)

    def small(shape, s):
        return s * jax.random.normal(next(ks), shape, f32)

    def gains(shape):
        return 1.0 + 0.05 * jax.random.normal(next(ks), shape, f32)

    x = jax.random.normal(next(ks), (BATCH, SEQ, D_MODEL), f32)
    c = jax.random.normal(next(ks), (BATCH, D_MODEL), f32)
    ctx = jax.random.normal(next(ks), (BATCH, CTX_LEN, D_MODEL), f32)
    c_ctx = jax.random.normal(next(ks), (D_MODEL,), f32)

    ada_w = nrm((DEPTH, D_MODEL, N_MOD * D_MODEL), D_MODEL, 0.5)
    ada_b = small((DEPTH, N_MOD * D_MODEL), 0.02)
    norm_g = gains((DEPTH, 4, D_MODEL))
    ffn_w_gu = nrm((DEPTH, D_MODEL, 2 * FFN_HIDDEN), D_MODEL)
    ffn_w_down = nrm((DEPTH, FFN_HIDDEN, D_MODEL), FFN_HIDDEN)

    a_w_qkv = nrm((n_a, D_MODEL, A_QKV), D_MODEL)
    a_sinks = small((n_a, A_HEADS), 1.0)
    a_w_o = nrm((n_a, A_HEADS * A_HEAD_DIM, D_MODEL), A_HEADS * A_HEAD_DIM)

    b_w_in = nrm((n_b, D_MODEL, 2 * B_WIDTH), D_MODEL)
    b_conv_w = nrm((n_b, B_CONV_W, B_WIDTH), B_CONV_W)
    b_conv_b = small((n_b, B_WIDTH), 0.02)
    a_pow = jax.random.uniform(next(ks), (n_b, 2, B_WIDTH), f32, minval=0.9, maxval=0.999)
    p_lam = a_pow ** (1.0 / B_LRU_C)
    b_lam = jnp.log(p_lam) - jnp.log1p(-p_lam)
    b_w_a = nrm((n_b, 2, B_BLOCKS, B_BLOCK_W, B_BLOCK_W), B_BLOCK_W)
    b_b_a = small((n_b, 2, B_WIDTH), 0.1)
    b_w_x = nrm((n_b, 2, B_BLOCKS, B_BLOCK_W, B_BLOCK_W), B_BLOCK_W)
    b_b_x = small((n_b, 2, B_WIDTH), 0.1)
    b_w_out = nrm((n_b, B_WIDTH, D_MODEL), B_WIDTH)

    c_w_in = nrm((n_c, D_MODEL, C_IN), D_MODEL)
    c_g_q = gains((n_c, C_Q_RANK))
    c_g_kv = gains((n_c, C_KV_RANK))
    c_w_uq = nrm((n_c, C_Q_RANK, C_HEADS * (C_NOPE + C_ROPE)), C_Q_RANK)
    c_w_ukv = nrm((n_c, C_KV_RANK, C_HEADS * (C_NOPE + C_VDIM)), C_KV_RANK)
    c_w_out = nrm((n_c, C_HEADS * C_VDIM, D_MODEL), C_HEADS * C_VDIM)

    return {'x': x, 'c': c, 'ctx': ctx, 'c_ctx': c_ctx,
            'ada_w': ada_w, 'ada_b': ada_b, 'norm_g': norm_g,
            'ffn_w_gu': ffn_w_gu, 'ffn_w_down': ffn_w_down,
            'a_w_qkv': a_w_qkv, 'a_sinks': a_sinks, 'a_w_o': a_w_o,
            'b_w_in': b_w_in, 'b_conv_w': b_conv_w, 'b_conv_b': b_conv_b, 'b_lam': b_lam,
            'b_w_a': b_w_a, 'b_b_a': b_b_a, 'b_w_x': b_w_x, 'b_b_x': b_b_x, 'b_w_out': b_w_out,
            'c_w_in': c_w_in, 'c_g_q': c_g_q, 'c_g_kv': c_g_kv, 'c_w_uq': c_w_uq,
            'c_w_ukv': c_w_ukv, 'c_w_out': c_w_out}


def reference(x, c, ctx, c_ctx, ada_w, ada_b, norm_g, ffn_w_gu, ffn_w_down,
              a_w_qkv, a_sinks, a_w_o,
              b_w_in, b_conv_w, b_conv_b, b_lam, b_w_a, b_b_a, b_w_x, b_b_x, b_w_out,
              c_w_in, c_g_q, c_g_kv, c_w_uq, c_w_ukv, c_w_out):
    n_tok = x.shape[1]
    cos_a, sin_a = axial_rope_tables(n_tok, A_HEAD_DIM)
    cos_c, sin_c = axial_rope_tables(n_tok, C_ROPE)
    s_lat = jax.nn.silu(c)
    s_ctx = jax.nn.silu(c_ctx)[None]
    xc = ctx
    for i in range(DEPTH):
        last = i == DEPTH - 1
        kind, j = i % N_MIXERS, i // N_MIXERS
        m = jnp.split((s_lat @ ada_w[i] + ada_b[i])[:, None, :], N_MOD, axis=-1)
        mc = jnp.split((s_ctx @ ada_w[i] + ada_b[i])[:, None, :], N_MOD, axis=-1)
        g = norm_g[i]
        h = modulate(rms_norm(x, g[0]), m[0], m[1])
        hc = modulate(rms_norm(xc, g[0]), mc[0], mc[1])
        if kind == 0:
            y, yc = windowed_gqa(h, hc, a_w_qkv[j], a_sinks[j], a_w_o[j], cos_a, sin_a, not last)
        elif kind == 1:
            y, yc = rglru_block(h, hc, b_w_in[j], b_conv_w[j], b_conv_b[j], b_lam[j], b_w_a[j], b_b_a[j],
                                b_w_x[j], b_b_x[j], b_w_out[j], not last)
        else:
            y, yc = mla(h, hc, c_w_in[j], c_g_q[j], c_g_kv[j], c_w_uq[j], c_w_ukv[j], c_w_out[j],
                        cos_c, sin_c, not last)
        x = x + m[2] * rms_norm(y, g[1])
        x = x + m[5] * rms_norm(swiglu(modulate(rms_norm(x, g[2]), m[3], m[4]), ffn_w_gu[i], ffn_w_down[i]), g[3])
        if not last:
            xc = xc + mc[2] * rms_norm(yc, g[1])
            xc = xc + mc[5] * rms_norm(swiglu(modulate(rms_norm(xc, g[2]), mc[3], mc[4]), ffn_w_gu[i], ffn_w_down[i]), g[3])
    return x
```

```cpp
#include <hip/hip_runtime.h>
#include <hip/hip_cooperative_groups.h>
#include <cstdio>
#include <cstring>
namespace cg = cooperative_groups;


typedef unsigned short bf16_t;
typedef short bf16x8 __attribute__((ext_vector_type(8)));
typedef float f32x4 __attribute__((ext_vector_type(4)));
typedef unsigned u32x2 __attribute__((ext_vector_type(2)));
typedef unsigned u32x4 __attribute__((ext_vector_type(4)));

constexpr int NT = 16640, NCTX = 256, TL = 16384, DM = 1024, FH = 2816, NRB = 130;
constexpr float RMS_EPS = 1e-6f;
constexpr float LOG2E = 1.4426950408889634f;

constexpr size_t E_GU = 5632ull * 1024, E_DN = 1024ull * 2816;
constexpr size_t WO_GU0 = 0;
__host__ __device__ constexpr size_t wo_gu(int l) { return (size_t)l * (E_GU + E_DN); }
__host__ __device__ constexpr size_t wo_dn(int l) { return wo_gu(l) + E_GU; }
constexpr size_t WO_A0 = 4 * (E_GU + E_DN);
__host__ __device__ constexpr size_t wo_aqkv(int j) { return WO_A0 + (size_t)j * (1536ull * 1024 + 1024ull * 1024); }
__host__ __device__ constexpr size_t wo_ao(int j) { return wo_aqkv(j) + 1536ull * 1024; }
constexpr size_t WO_BIN = WO_A0 + 2 * (1536ull * 1024 + 1024ull * 1024);
constexpr size_t WO_BG = WO_BIN + 2048ull * 1024;
constexpr size_t WO_BOUT = WO_BG + 4096ull * 256;
constexpr size_t WO_CIN = WO_BOUT + 1024ull * 1024;
constexpr size_t WO_CUQ = WO_CIN + 1024ull * 1024;
constexpr size_t WO_CUKV = WO_CUQ + 1536ull * 512;
constexpr size_t WO_COUT = WO_CUKV + 2048ull * 256;
constexpr size_t WO_END = WO_COUT + 1024ull * 1024;

constexpr size_t OFF_WB = 0;
constexpr size_t OFF_MOD = OFF_WB + WO_END * 2;
constexpr size_t OFF_ROPEA = OFF_MOD + 4 * 2 * 6144 * 4;
constexpr size_t OFF_ROPEC = OFF_ROPEA + 2 * 256 * 32 * 4;
constexpr size_t OFF_GBIAS = OFF_ROPEC + 2 * 256 * 16 * 4;
constexpr size_t OFF_SS = OFF_GBIAS + 4096 * 4;
constexpr size_t OFF_SCAN = OFF_SS + (size_t)NT * 2 * 4;
constexpr size_t OFF_BAR = OFF_SCAN + 2ull * 2 * NRB * 1024 * 4;
constexpr size_t OFF_XC = OFF_BAR + 16384;
constexpr size_t OFF_H = OFF_XC + 256ull * 1024 * 4;
constexpr size_t OFF_Y = OFF_H + (size_t)NT * 1024 * 2;
constexpr size_t OFF_BIG = OFF_Y + (size_t)NT * 1024 * 4;
constexpr size_t SZ_ROW1K = (size_t)NT * 1024 * 2;
constexpr size_t WS_NEED = OFF_BIG + 4 * SZ_ROW1K;
constexpr size_t BA_Q = 0, BA_K = SZ_ROW1K, BA_VT = BA_K + (size_t)NT * 256 * 2;
constexpr size_t BB_GATES = 0;
constexpr size_t OFF_ZX = OFF_Y + SZ_ROW1K;
constexpr size_t OFF_ZQ = OFF_Y, OFF_ZKV = OFF_ZQ + (size_t)NT * 512 * 2, OFF_KR = OFF_ZKV + (size_t)NT * 256 * 2;
constexpr size_t BC_QC = 0, BC_KN = BC_QC + (size_t)NT * 1536 * 2, BC_VT = BC_KN + SZ_ROW1K;
static_assert(BC_VT + SZ_ROW1K <= 4 * SZ_ROW1K, "layer C overflow");
static_assert((size_t)NT * FH * 2 <= 4 * SZ_ROW1K, "ffn hid overflow");
static_assert(BA_VT + (size_t)NT * 256 * 2 <= 4 * SZ_ROW1K, "layer A overflow");

struct ConvJob { const float* src; bf16_t* dst; const float* kscale; int K, N, ld, mode, rmul, roff, tile0, pad; };
constexpr int NJOBS = 34;
struct Params {
    const float* in[27];
    float* out;
    char* ws;
    ConvJob jobs[NJOBS];
    int conv_tiles;
    int pad;
};

typedef float f32x2_t __attribute__((ext_vector_type(2)));
typedef __bf16 bf16x2_t __attribute__((ext_vector_type(2)));
__device__ __forceinline__ unsigned cvt_pk(float lo, float hi) { f32x2_t v = {lo, hi}; bf16x2_t b = __builtin_convertvector(v, bf16x2_t); return __builtin_bit_cast(unsigned, b); }
__device__ __forceinline__ float bf2f(unsigned h) { return __uint_as_float(h << 16); }
__device__ __forceinline__ float bflo(unsigned w) { return __uint_as_float(w << 16); }
__device__ __forceinline__ float bfhi(unsigned w) { return __uint_as_float(w & 0xffff0000u); }
__device__ __forceinline__ float fast_exp2(float x) { return __builtin_amdgcn_exp2f(x); }
__device__ __forceinline__ float sigmoidf_(float x) { return 1.0f / (1.0f + __expf(-x)); }
__device__ __forceinline__ float siluf_(float x) { return x * __builtin_amdgcn_rcpf(1.0f + __builtin_amdgcn_exp2f(-LOG2E * x)); }
__device__ __forceinline__ float gelu_tanh(float x) {
    const float u = 0.7978845608028654f * (x + 0.044715f * x * x * x);
    const float e = __expf(2.0f * u);
    const float t = 1.0f - 2.0f * __builtin_amdgcn_rcpf(e + 1.0f);
    return 0.5f * x * (1.0f + t);
}
__device__ __forceinline__ float wave_sum(float v) {
#pragma unroll
    for (int o = 32; o > 0; o >>= 1) v += __shfl_xor(v, o);
    return v;
}

__device__ __forceinline__ int tid_() { int t = threadIdx.x; asm volatile("" : "+v"(t)); return t; }


namespace pg8 {
#define PG8_LAS __attribute__((address_space(3)))
typedef unsigned short bf16_t;
typedef short bf16x8 __attribute__((ext_vector_type(8)));
typedef float f32x4 __attribute__((ext_vector_type(4)));
typedef unsigned u32x4 __attribute__((ext_vector_type(4)));
constexpr int BM = 256, BK = 64, HALF = 128, HTB = HALF * BK * 2  , STAGE_BYTES = 8 * HTB, NXCD = 8, WGM = 8;

__host__ __device__ __forceinline__ int lds_byte(int r, int c) { const int st = (r >> 4) * 2 + (c >> 5), rr = r & 15, cc = c & 31, ob = rr * 64 + cc * 2; return st * 1024 + (ob ^ (((ob >> 9) & 1) << 5)); }
__host__ __device__ __forceinline__ void stage_rc(int b, int& R, int& C) { const int st = b / 1024, sb = b % 1024, swz = sb ^ (((sb >> 9) & 1) << 5); R = (st >> 1) * 16 + swz / 64; C = (st & 1) * 32 + (swz % 64) / 2; }
__host__ __device__ __forceinline__ int perm32(int rho) { const int n = rho >> 4, i = rho & 15; return 8 * (i >> 2) + 4 * n + (i & 3); }

struct Unit { int pm, pn; };
struct Gemm { const bf16_t* A; const bf16_t* Bt; int M, N, K, lda, bdiag; };

struct StaticOrder {
    int nM, nN, nwg, G, c;
    __host__ __device__ void init(int M, int N, int G_, int c_) { nM = M / BM; nN = N / BM; nwg = nM * nN; G = G_; c = c_; }
    __host__ __device__ bool next(int i, Unit& u) const {
        const long L = (long)i * G + c; if (L >= nwg) return false;
        int wgid = (int)L; { const int q = nwg / NXCD, r = nwg % NXCD, xcd = wgid % NXCD, off = wgid / NXCD; wgid = (xcd < r ? xcd * (q + 1) : r * (q + 1) + (xcd - r) * q) + off; }
        const int nig = WGM * nN, gid = wgid / nig, fm = gid * WGM, gsz = (nM - fm) < WGM ? (nM - fm) : WGM;
        u.pm = fm + ((wgid % nig) % gsz); u.pn = (wgid % nig) / gsz; return true;
    }
    __device__ __forceinline__ void a_ready(const Unit&) const {}
    __device__ __forceinline__ void done(const Unit&) const {}
};
template <class Epi, class Sched, bool ALIGN_EPI = false, bool SP2 = false>
__device__ __forceinline__ void gemm_phase(PG8_LAS unsigned char* lds, const Gemm g, const Sched& S, const Epi& E) {
    const int tid = tid_(), wid = __builtin_amdgcn_readfirstlane(tid >> 6), lane = tid & 63, wr = wid >> 2, wc = wid & 3, fr = lane & 15, fq = lane >> 4;
    const int K = g.K, nt = K / BK;
    unsigned voffA[2], voffB[2];
#pragma unroll
    for (int i = 0; i < 2; ++i) { int R, C; stage_rc(tid * 16 + i * 8192, R, C); const int Rb = Epi::PERM ? ((R & ~31) + perm32(R & 31)) : R;
        voffA[i] = (unsigned)(R * g.lda + C) * 2u; voffB[i] = (unsigned)(Rb * K + C) * 2u; }
    const size_t kstep = (size_t)(BK * 2);
    const size_t hstep = (size_t)HALF * K * 2;
    const size_t tstep = 2 * hstep; const size_t hstepA = (size_t)HALF * g.lda * 2, tstepA = 2 * hstepA;
    const unsigned ldsw = (unsigned)wid * 1024u;
    const int aoff = lds_byte(wr * 64 + fr, fq * 8), boff = lds_byte(wc * 32 + fr, fq * 8);
#define PG8_SA(b, h) (((b) * 2 + (h)) * HTB)
#define PG8_SB(b, h) ((4 + (b) * 2 + (h)) * HTB)
#define PG8_STAGE(bufoff, gbase, voff) do { _Pragma("unroll") for (int _i = 0; _i < 2; ++_i) \
        __builtin_amdgcn_global_load_lds((const unsigned*)((const char*)(gbase) + (voff)[_i]), (PG8_LAS unsigned*)(lds + (bufoff) + ldsw + _i * 8192), 16, 0, 0); } while (0)
#define PG8_LDA(dst, b, h) do { _Pragma("unroll") for (int m = 0; m < 4; ++m) _Pragma("unroll") for (int k = 0; k < 2; ++k) dst[m][k] = *(const PG8_LAS bf16x8*)(lds + PG8_SA(b, h) + aoff + m * 2048 + k * 1024); } while (0)
#define PG8_LDB(dst, b, h) do { _Pragma("unroll") for (int n = 0; n < 2; ++n) _Pragma("unroll") for (int k = 0; k < 2; ++k) dst[n][k] = *(const PG8_LAS bf16x8*)(lds + PG8_SB(b, h) + boff + n * 2048 + k * 1024); } while (0)
#define PG8_MMA(ai, bj, At, Bt) do { __builtin_amdgcn_s_setprio(1); _Pragma("unroll") for (int m = 0; m < 4; ++m) _Pragma("unroll") for (int n = 0; n < 2; ++n) _Pragma("unroll") for (int k = 0; k < 2; ++k) \
        acc[ai][bj][m][n] = __builtin_amdgcn_mfma_f32_16x16x32_bf16(Bt[n][k], At[m][k], acc[ai][bj][m][n], 0, 0, 0); __builtin_amdgcn_s_setprio(0); } while (0)
#define PG8_WAIT_V(n) asm volatile("s_waitcnt vmcnt(" #n ")" ::: "memory")
#define PG8_WAIT_L(n) asm volatile("s_waitcnt lgkmcnt(" #n ")" ::: "memory")
#define PG8_BAR __builtin_amdgcn_s_barrier()
#define PG8_SCHED __builtin_amdgcn_sched_barrier(0)
    Unit cur, nxt; int ui = 0;
    if (!S.next(0, cur)) return;
    f32x4 acc[2][2][4][2];
#pragma unroll
    for (int a = 0; a < 2; ++a)
#pragma unroll
        for (int b = 0; b < 2; ++b)
#pragma unroll
            for (int m = 0; m < 4; ++m)
#pragma unroll
                for (int n = 0; n < 2; ++n) acc[a][b][m][n] = (f32x4){0.f, 0.f, 0.f, 0.f};
    bf16x8 At[4][2], B0[2][2], B1[2][2];
    const char* cA = (const char*)g.A + (size_t)cur.pm * tstepA + (g.bdiag ? ((cur.pn & 7) >> 1) * 512 : 0); const char* cB = (const char*)g.Bt + (size_t)cur.pn * tstep;
    S.a_ready(cur);
    if constexpr (SP2) {
        PG8_STAGE(PG8_SB(0, 0), cB, voffB); PG8_STAGE(PG8_SB(0, 1), cB + hstep, voffB); PG8_STAGE(PG8_SA(0, 0), cA, voffA); PG8_STAGE(PG8_SA(0, 1), cA + hstepA, voffA);
        if (wr == 1) PG8_BAR;
        PG8_WAIT_V(2); PG8_BAR;
        PG8_STAGE(PG8_SB(1, 0), cB + kstep, voffB); PG8_STAGE(PG8_SA(1, 0), cA + kstep, voffA); PG8_STAGE(PG8_SB(1, 1), cB + hstep + kstep, voffB);
        PG8_WAIT_V(6); PG8_BAR;
    } else {
        PG8_STAGE(PG8_SB(0, 0), cB, voffB); PG8_STAGE(PG8_SA(0, 0), cA, voffA); PG8_STAGE(PG8_SB(0, 1), cB + hstep, voffB); PG8_STAGE(PG8_SA(0, 1), cA + hstepA, voffA);
        if (wr == 1) PG8_BAR;
        PG8_WAIT_V(4); PG8_BAR;
        PG8_STAGE(PG8_SB(1, 0), cB + kstep, voffB); PG8_STAGE(PG8_SA(1, 0), cA + kstep, voffA); PG8_STAGE(PG8_SB(1, 1), cB + hstep + kstep, voffB);
        PG8_WAIT_V(6); PG8_BAR;
    }
    for (;;) {
        const bool has_next = S.next(ui + 1, nxt);
        const char* nA = has_next ? (const char*)g.A + (size_t)nxt.pm * tstepA + (g.bdiag ? ((nxt.pn & 7) >> 1) * 512 : 0) : cA; const char* nB = has_next ? (const char*)g.Bt + (size_t)nxt.pn * tstep : cB;
        for (int t = 0; t < nt; t += 2) {
            const bool last = (t == nt - 2);
            const char* a1 = cA + (size_t)(t + 1) * kstep;
            const char* a2 = last ? nA : cA + (size_t)(t + 2) * kstep; const char* b2 = last ? nB : cB + (size_t)(t + 2) * kstep;
            const char* a3 = a2 + kstep; const char* b3 = b2 + kstep;
            if (last && has_next) S.a_ready(nxt);
            if constexpr (SP2) {
            PG8_LDB(B0, 0, 0); PG8_LDB(B1, 0, 1); PG8_SCHED; PG8_LDA(At, 0, 0); PG8_STAGE(PG8_SA(1, 1), a1 + hstepA, voffA);
            PG8_WAIT_V(8); PG8_WAIT_L(0); PG8_BAR; PG8_MMA(0, 0, At, B0); PG8_MMA(0, 1, At, B1); PG8_BAR; PG8_SCHED;
            PG8_LDA(At, 0, 1); PG8_STAGE(PG8_SB(0, 0), b2, voffB); PG8_STAGE(PG8_SB(0, 1), b2 + hstep, voffB); PG8_STAGE(PG8_SA(0, 0), a2, voffA);
            PG8_WAIT_V(8); PG8_WAIT_L(0); PG8_BAR; PG8_MMA(1, 0, At, B0); PG8_MMA(1, 1, At, B1); PG8_BAR; PG8_SCHED;
            PG8_LDB(B0, 1, 0); PG8_LDB(B1, 1, 1); PG8_SCHED; PG8_LDA(At, 1, 0); PG8_STAGE(PG8_SA(0, 1), a2 + hstepA, voffA);
            PG8_WAIT_V(8); PG8_WAIT_L(0); PG8_BAR; PG8_MMA(0, 0, At, B0); PG8_MMA(0, 1, At, B1); PG8_BAR; PG8_SCHED;
            PG8_LDA(At, 1, 1); PG8_STAGE(PG8_SB(1, 0), b3, voffB); PG8_STAGE(PG8_SB(1, 1), b3 + hstep, voffB); PG8_STAGE(PG8_SA(1, 0), a3, voffA);
            PG8_WAIT_V(8); PG8_WAIT_L(0); PG8_BAR; PG8_MMA(1, 0, At, B0); PG8_MMA(1, 1, At, B1); PG8_BAR; PG8_SCHED;
            } else {
            PG8_LDB(B0, 0, 0); PG8_SCHED; PG8_LDA(At, 0, 0); PG8_STAGE(PG8_SA(1, 1), a1 + hstepA, voffA);
            PG8_WAIT_L(8); PG8_BAR; PG8_WAIT_L(0); PG8_MMA(0, 0, At, B0); PG8_BAR; PG8_SCHED;
            PG8_LDB(B1, 0, 1); PG8_STAGE(PG8_SB(0, 0), b2, voffB);
            PG8_BAR; PG8_WAIT_L(0); PG8_MMA(0, 1, At, B1); PG8_BAR;
            PG8_LDA(At, 0, 1); PG8_STAGE(PG8_SA(0, 0), a2, voffA);
            PG8_BAR; PG8_WAIT_L(0); PG8_MMA(1, 0, At, B0); PG8_BAR; PG8_SCHED;
            PG8_STAGE(PG8_SB(0, 1), b2 + hstep, voffB);
            PG8_WAIT_V(6); PG8_BAR; PG8_MMA(1, 1, At, B1); PG8_BAR;
            PG8_LDB(B0, 1, 0); PG8_SCHED; PG8_LDA(At, 1, 0); PG8_STAGE(PG8_SA(0, 1), a2 + hstepA, voffA);
            PG8_WAIT_L(8); PG8_BAR; PG8_WAIT_L(0); PG8_MMA(0, 0, At, B0); PG8_BAR; PG8_SCHED;
            PG8_LDB(B1, 1, 1); PG8_STAGE(PG8_SB(1, 0), b3, voffB);
            PG8_BAR; PG8_WAIT_L(0); PG8_MMA(0, 1, At, B1); PG8_BAR;
            PG8_LDA(At, 1, 1); PG8_STAGE(PG8_SA(1, 0), a3, voffA);
            PG8_BAR; PG8_WAIT_L(0); PG8_MMA(1, 0, At, B0); PG8_BAR; PG8_SCHED;
            PG8_STAGE(PG8_SB(1, 1), b3 + hstep, voffB);
            PG8_WAIT_V(6); PG8_BAR; PG8_MMA(1, 1, At, B1); PG8_BAR;
            }
        }
        if constexpr (ALIGN_EPI) { if (wr == 0) PG8_BAR; }
        if constexpr (!Epi::AFTER_DRAIN) { E(acc, cur, wr, wc, fr, fq); S.done(cur); }
        if (!has_next) break;
#pragma unroll
        for (int a = 0; a < 2; ++a)
#pragma unroll
            for (int b = 0; b < 2; ++b)
#pragma unroll
                for (int m = 0; m < 4; ++m)
#pragma unroll
                    for (int n = 0; n < 2; ++n) acc[a][b][m][n] = (f32x4){0.f, 0.f, 0.f, 0.f};
        cur = nxt; cA = nA; cB = nB; ++ui;
        if constexpr (ALIGN_EPI) { if (wr == 1) PG8_BAR; }
    }
    PG8_WAIT_V(0);
    if constexpr (!ALIGN_EPI) { if (wr == 0) PG8_BAR; }
    PG8_BAR;
    if constexpr (Epi::AFTER_DRAIN) { E.fused(acc, cur, wr, wc, fr, fq, lds, wid, lane); S.done(cur); }
#undef PG8_SA
#undef PG8_SB
#undef PG8_STAGE
#undef PG8_LDA
#undef PG8_LDB
#undef PG8_MMA
#undef PG8_WAIT_V
#undef PG8_WAIT_L
#undef PG8_BAR
#undef PG8_SCHED
}
}
using pg8::Unit;
#define EROW(ai, m) (u.pm * 256 + (ai) * 128 + wr * 64 + (m) * 16 + fr)
#define ECOL(bj, n) (u.pn * 256 + (bj) * 128 + wc * 32 + (n) * 16 + fq * 4)
typedef f32x4 acc_t[2][2][4][2];
__device__ __forceinline__ u32x2 pack4(const f32x4 v) { u32x2 w; w.x = cvt_pk(v[0], v[1]); w.y = cvt_pk(v[2], v[3]); return w; }

__device__ __forceinline__ int vt_pos(int t4) { return (t4 & ~31) + ((t4 & 12) << 1) + ((t4 & 16) >> 2); }
struct EpiF32 {
    static constexpr bool PERM = false, AFTER_DRAIN = false;
    bf16_t* Y; int ldc;
    __device__ __forceinline__ void operator()(const acc_t& acc, const Unit& u, int wr, int wc, int fr, int fq) const {
#pragma unroll
        for (int ai = 0; ai < 2; ++ai)
#pragma unroll
            for (int m = 0; m < 4; ++m)
#pragma unroll
                for (int bj = 0; bj < 2; ++bj)
#pragma unroll
                    for (int n = 0; n < 2; ++n) *(u32x2*)(Y + (size_t)EROW(ai, m) * ldc + ECOL(bj, n)) = pack4(acc[ai][bj][m][n]);
    }
};
struct EpiQK {
    static constexpr bool PERM = false, AFTER_DRAIN = false;
    bf16_t* Q; bf16_t* Kb; bf16_t* VT; const float* cosT; const float* sinT; float qscale;
    __device__ __forceinline__ void operator()(const acc_t& acc, const Unit& u, int wr, int wc, int fr, int fq) const {
        if (u.pn == 5) {
            const int b = fr & 3;
#pragma unroll
            for (int ai = 0; ai < 2; ++ai)
#pragma unroll
                for (int m = 0; m < 4; ++m)
#pragma unroll
                    for (int bj = 0; bj < 2; ++bj)
#pragma unroll
                        for (int n = 0; n < 2; ++n) {
                            f32x4 v = acc[ai][bj][m][n];
                            { const float t0 = (b & 1) ? v[0] : v[1], t1 = (b & 1) ? v[2] : v[3];
                              const float r0 = __shfl_xor(t0, 1), r1 = __shfl_xor(t1, 1);
                              if (b & 1) { v[0] = r0; v[2] = r1; } else { v[1] = r0; v[3] = r1; } }
                            { const float t0 = (b & 2) ? v[0] : v[2], t1 = (b & 2) ? v[1] : v[3];
                              const float r0 = __shfl_xor(t0, 2), r1 = __shfl_xor(t1, 2);
                              if (b & 2) { v[0] = r0; v[1] = r1; } else { v[2] = r0; v[3] = r1; } }
                            const int col = ECOL(bj, n) - 1280 + b, row = EROW(ai, m) - b;
                            *(u32x2*)(VT + (size_t)col * NT + vt_pos(row)) = pack4(v);
                        }
            return;
        }
        const bool isq = u.pn < 4;
        const float sc = isq ? qscale : 1.0f;
        const int axis = wc >> 1, fh = wc & 1;
#pragma unroll
        for (int ai = 0; ai < 2; ++ai)
#pragma unroll
            for (int m = 0; m < 4; ++m) {
                const int row = EROW(ai, m);
                f32x4 c = (f32x4){1.f, 1.f, 1.f, 1.f}, s = (f32x4){0.f, 0.f, 0.f, 0.f};
                if (row >= NCTX) {
                    const int t = row - NCTX, pos = axis ? (t & 63) : (t >> 6);
                    c = *(const f32x4*)(cosT + pos * 32 + fh * 16 + fq * 4);
                    s = *(const f32x4*)(sinT + pos * 32 + fh * 16 + fq * 4);
                }
#pragma unroll
                for (int bj = 0; bj < 2; ++bj) {
                    const f32x4 x1 = acc[ai][bj][m][0], x2 = acc[ai][bj][m][1];
                    const f32x4 o1 = (x1 * c - x2 * s) * sc, o2 = (x2 * c + x1 * s) * sc;
                    if (isq) { *(u32x2*)(Q + (size_t)row * 1024 + ECOL(bj, 0)) = pack4(o1); *(u32x2*)(Q + (size_t)row * 1024 + ECOL(bj, 1)) = pack4(o2); }
                    else { *(u32x2*)(Kb + (size_t)row * 256 + ECOL(bj, 0) - 1024) = pack4(o1); *(u32x2*)(Kb + (size_t)row * 256 + ECOL(bj, 1) - 1024) = pack4(o2); }
                }
            }
    }
};
struct EpiVT {
    static constexpr bool PERM = false, AFTER_DRAIN = false;
    bf16_t* VT; const float* ss; int ssidx; float inv_dim;
    __device__ __forceinline__ void operator()(const acc_t& acc, const Unit& u, int wr, int wc, int fr, int fq) const {
#pragma unroll
        for (int bj = 0; bj < 2; ++bj)
#pragma unroll
            for (int n = 0; n < 2; ++n) {
                const int col = ECOL(bj, n);
                f32x4 rs = (f32x4){1.f, 1.f, 1.f, 1.f};
                if (ss) {
#pragma unroll
                    for (int i = 0; i < 4; ++i) rs[i] = rsqrtf(ss[(col + i) * 2 + ssidx] * inv_dim + RMS_EPS);
                }
#pragma unroll
                for (int ai = 0; ai < 2; ++ai)
#pragma unroll
                    for (int m = 0; m < 4; ++m) *(u32x2*)(VT + (size_t)EROW(ai, m) * NT + vt_pos(col)) = pack4(acc[ai][bj][m][n] * rs);
            }
    }
};
struct EpiBin {
    static constexpr bool PERM = false, AFTER_DRAIN = false;
    bf16_t* ZX; bf16_t* G;
    __device__ __forceinline__ void operator()(const acc_t& acc, const Unit& u, int wr, int wc, int fr, int fq) const {
        const bool isg = u.pn >= 4;
        bf16_t* dst = isg ? G : ZX;
#pragma unroll
        for (int ai = 0; ai < 2; ++ai)
#pragma unroll
            for (int m = 0; m < 4; ++m)
#pragma unroll
                for (int bj = 0; bj < 2; ++bj)
#pragma unroll
                    for (int n = 0; n < 2; ++n) {
                        f32x4 v = acc[ai][bj][m][n];
                        if (isg) { v[0] = gelu_tanh(v[0]); v[1] = gelu_tanh(v[1]); v[2] = gelu_tanh(v[2]); v[3] = gelu_tanh(v[3]); }
                        *(u32x2*)(dst + (size_t)EROW(ai, m) * 1024 + (ECOL(bj, n) & 1023)) = pack4(v);
                    }
    }
};
struct EpiGates {
    static constexpr bool PERM = false, AFTER_DRAIN = false;
    bf16_t* O; const float* bias;
    __device__ __forceinline__ void operator()(const acc_t& acc, const Unit& u, int wr, int wc, int fr, int fq) const {
#pragma unroll
        for (int ai = 0; ai < 2; ++ai)
#pragma unroll
            for (int m = 0; m < 4; ++m) {
                bf16_t* orow = O + (size_t)EROW(ai, m) * 4096;
#pragma unroll
                for (int bj = 0; bj < 2; ++bj)
#pragma unroll
                    for (int n = 0; n < 2; ++n) {
                        const int col = ECOL(bj, n);
                        const f32x4 v = (acc[ai][bj][m][n] + *(const f32x4*)(bias + col)) * (-LOG2E);
                        f32x4 sg;
#pragma unroll
                        for (int i = 0; i < 4; ++i) sg[i] = __builtin_amdgcn_rcpf(1.0f + fast_exp2(v[i]));
                        *(u32x2*)(orow + col) = pack4(sg);
                    }
                asm volatile("" ::: "memory");
            }
    }
};
struct EpiCin {
    static constexpr bool PERM = false, AFTER_DRAIN = false;
    bf16_t* ZQ; bf16_t* ZKV; bf16_t* KR; float* ss; const float* cosT; const float* sinT;
    __device__ __forceinline__ void operator()(const acc_t& acc, const Unit& u, int wr, int wc, int fr, int fq) const {
        if (u.pn < 3) {
            const int which = u.pn < 2 ? 0 : 1;
#pragma unroll
            for (int ai = 0; ai < 2; ++ai)
#pragma unroll
                for (int m = 0; m < 4; ++m) {
                    const int row = EROW(ai, m);
                    float s = 0.f;
#pragma unroll
                    for (int bj = 0; bj < 2; ++bj)
#pragma unroll
                        for (int n = 0; n < 2; ++n) {
                            const f32x4 v = acc[ai][bj][m][n];
                            s += v[0] * v[0] + v[1] * v[1] + v[2] * v[2] + v[3] * v[3];
                            if (which == 0) *(u32x2*)(ZQ + (size_t)row * 512 + ECOL(bj, n)) = pack4(v);
                            else *(u32x2*)(ZKV + (size_t)row * 256 + ECOL(bj, n) - 512) = pack4(v);
                        }
                    s += __shfl_xor(s, 16); s += __shfl_xor(s, 32);
                    if (fq == 0) atomicAdd(ss + row * 2 + which, s);
                }
        } else if (wc < 2) {
#pragma unroll
            for (int ai = 0; ai < 2; ++ai)
#pragma unroll
                for (int m = 0; m < 4; ++m) {
                    const int row = EROW(ai, m);
                    f32x4 x1 = acc[ai][0][m][0], x2 = acc[ai][0][m][1];
                    if (row >= NCTX) {
                        const int t = row - NCTX, pos = wc ? (t & 63) : (t >> 6);
                        const f32x4 c = *(const f32x4*)(cosT + pos * 16 + 4 * fq);
                        const f32x4 s = *(const f32x4*)(sinT + pos * 16 + 4 * fq);
                        const f32x4 o1 = x1 * c - x2 * s, o2 = x2 * c + x1 * s;
                        x1 = o1; x2 = o2;
                    }
                    *(u32x2*)(KR + (size_t)row * 64 + wc * 32 + fq * 4) = pack4(x1);
                    *(u32x2*)(KR + (size_t)row * 64 + wc * 32 + 16 + fq * 4) = pack4(x2);
                }
        }
    }
};
struct EpiQc {
    static constexpr bool PERM = false, AFTER_DRAIN = false;
    bf16_t* QC; const float* ss; const float* cosT; const float* sinT; float qscale;
    __device__ __forceinline__ void operator()(const acc_t& acc, const Unit& u, int wr, int wc, int fr, int fq) const {
#pragma unroll
        for (int ai = 0; ai < 2; ++ai)
#pragma unroll
            for (int m = 0; m < 4; ++m) {
                const int row = EROW(ai, m);
                const float rs = rsqrtf(ss[row * 2] * (1.0f / 512.0f) + RMS_EPS) * qscale;
#pragma unroll
                for (int bj = 0; bj < 2; ++bj) {
                    const int cb = u.pn * 256 + bj * 128 + wc * 32;
                    const int grp = (cb % 192) >> 5;
                    f32x4 x1 = acc[ai][bj][m][0], x2 = acc[ai][bj][m][1];
                    if (grp >= 4 && row >= NCTX) {
                        const int t = row - NCTX, pos = (grp == 5) ? (t & 63) : (t >> 6);
                        const f32x4 c = *(const f32x4*)(cosT + pos * 16 + 4 * fq);
                        const f32x4 s = *(const f32x4*)(sinT + pos * 16 + 4 * fq);
                        const f32x4 o1 = x1 * c - x2 * s, o2 = x2 * c + x1 * s;
                        x1 = o1; x2 = o2;
                    }
                    *(u32x2*)(QC + (size_t)row * 1536 + cb + fq * 4) = pack4(x1 * rs);
                    *(u32x2*)(QC + (size_t)row * 1536 + cb + 16 + fq * 4) = pack4(x2 * rs);
                }
            }
    }
};
struct EpiKn {
    static constexpr bool PERM = false, AFTER_DRAIN = false;
    bf16_t* KN; const float* ss;
    __device__ __forceinline__ void operator()(const acc_t& acc, const Unit& u, int wr, int wc, int fr, int fq) const {
#pragma unroll
        for (int ai = 0; ai < 2; ++ai)
#pragma unroll
            for (int m = 0; m < 4; ++m) {
                const int row = EROW(ai, m);
                const float rs = rsqrtf(ss[row * 2 + 1] * (1.0f / 256.0f) + RMS_EPS);
#pragma unroll
                for (int bj = 0; bj < 2; ++bj)
#pragma unroll
                    for (int n = 0; n < 2; ++n) *(u32x2*)(KN + (size_t)row * 1024 + ECOL(bj, n)) = pack4(acc[ai][bj][m][n] * rs);
            }
    }
};
struct EpiGU {
    static constexpr bool PERM = false, AFTER_DRAIN = false;
    bf16_t* HID;
    __device__ __forceinline__ void operator()(const acc_t& acc, const Unit& u, int wr, int wc, int fr, int fq) const {
#pragma unroll
        for (int ai = 0; ai < 2; ++ai)
#pragma unroll
            for (int m = 0; m < 4; ++m) {
                const int row = EROW(ai, m);
#pragma unroll
                for (int bj = 0; bj < 2; ++bj) {
                    const int u0 = ((u.pn * 256 + bj * 128 + wc * 32) >> 5) * 16;
                    const f32x4 a = acc[ai][bj][m][0], b = acc[ai][bj][m][1];
                    const f32x4 h = (f32x4){siluf_(a[0]) * b[0], siluf_(a[1]) * b[1], siluf_(a[2]) * b[2], siluf_(a[3]) * b[3]};
                    *(u32x2*)(HID + (size_t)row * FH + u0 + fq * 4) = pack4(h);
                }
            }
    }
};
template <class Epi, bool ALIGN = true>
__device__ __forceinline__ void gemm(char* smem, const bf16_t* A, int lda, const bf16_t* Bt, int M, int N, int K, int bdiag, int rot, const Epi& e) {
    pg8::Gemm g{A, Bt, M, N, K, lda, bdiag};
    pg8::StaticOrder S; S.init(M, N, (int)gridDim.x, (int)((blockIdx.x + rot) % gridDim.x));
    pg8::gemm_phase<Epi, pg8::StaticOrder, ALIGN, true>((PG8_LAS unsigned char*)smem, g, S, e);
}

__device__ __forceinline__ void ctx_gemm_f32(char* smem, const bf16_t* __restrict__ A, int lda, const bf16_t* __restrict__ Bt, int K, bf16_t* __restrict__ Y) {
    const int tid = tid_(), lane = tid & 63, wid = tid >> 6, l16 = lane & 15, g = lane >> 4;
    f32x4* red = (f32x4*)smem;
    for (int t = blockIdx.x; t < 256; t += gridDim.x) {
        const int r0 = (t >> 4) * 16, c0 = (t & 15) * 64;
        const int kper = K >> 3, kbeg = wid * kper;
        const bf16_t* ap = A + (size_t)(r0 + l16) * lda + kbeg + g * 8;
        const bf16_t* bp = Bt + (size_t)(c0 + l16) * K + kbeg + g * 8;
        f32x4 acc[4];
#pragma unroll
        for (int n = 0; n < 4; ++n) acc[n] = (f32x4){0.f, 0.f, 0.f, 0.f};
#pragma unroll 4
        for (int k = 0; k < kper; k += 32) {
            const bf16x8 af = *(const bf16x8*)(ap + k);
#pragma unroll
            for (int n = 0; n < 4; ++n) {
                const bf16x8 bf = *(const bf16x8*)(bp + (size_t)n * 16 * K + k);
                acc[n] = __builtin_amdgcn_mfma_f32_16x16x32_bf16(bf, af, acc[n], 0, 0, 0);
            }
        }
        __syncthreads();
#pragma unroll
        for (int n = 0; n < 4; ++n) red[(wid * 4 + n) * 64 + lane] = acc[n];
        __syncthreads();
        if (tid < 256) {
            const int n = tid >> 6, ln = tid & 63;
            f32x4 sum = red[n * 64 + ln];
#pragma unroll
            for (int w = 1; w < 8; ++w) sum += red[(w * 4 + n) * 64 + ln];
            *(u32x2*)(Y + (size_t)(r0 + (ln & 15)) * 1024 + c0 + 16 * n + 4 * (ln >> 4)) = pack4(sum);
        }
    }
    __syncthreads();
}

__device__ __forceinline__ float xmax16_32(float x) {
    const unsigned xb = __float_as_uint(x);
    const auto r16 = __builtin_amdgcn_permlane16_swap(xb, xb, false, false);
    const float a = fmaxf(__uint_as_float(r16[0]), __uint_as_float(r16[1]));
    const unsigned ab = __float_as_uint(a);
    const auto r32 = __builtin_amdgcn_permlane32_swap(ab, ab, false, false);
    return fmaxf(__uint_as_float(r32[0]), __uint_as_float(r32[1]));
}
#ifndef ATT_SKEW
#define ATT_SKEW 10
#endif
template <int DQK, bool WINDOW>
__device__ __forceinline__ void attn_run(const bf16_t* __restrict__ Q, int ldq, const bf16_t* __restrict__ Kn, int ldk, int hdiv,
                                         const bf16_t* __restrict__ KR, const bf16_t* __restrict__ VT, bf16_t* __restrict__ O,
                                         const float* __restrict__ sinks, char* smem) {
    constexpr int KSTR = DQK * 2 + 16, VSTR = 144, NKC = DQK / 64, NKK = DQK / 32, KBUF = 64 * KSTR, VBUF = 128 * VSTR;
    char* Ks0 = smem;
    char* Vs0 = smem + 2 * KBUF;
    const int tid = tid_(), lane = tid & 63, wid = tid >> 6, l16 = lane & 15, g = lane >> 4;
    for (int u = blockIdx.x; u < 520; u += gridDim.x) {
        const bool ctxq = u >= 512;
        const int h = WINDOW ? (u & 1) * 4 + (wid >> 1) : (ctxq ? u - 512 : (u & 7));
        const int row0 = WINDOW ? (ctxq ? 64 * ((u - 512) >> 1) : NCTX + 64 * (u >> 1)) : (ctxq ? 0 : NCTX + 256 * (u >> 3));
        const int wrow = WINDOW ? 32 * (wid & 1) : 32 * wid;
        const int hk = WINDOW ? (u & 1) : h / hdiv;
        int lo = NCTX, hi = NT;
        if (WINDOW) { const int p0 = row0 - NCTX; lo = NCTX + (p0 - 128 > 0 ? p0 - 128 : 0); hi = NCTX + (p0 + 192 < TL ? p0 + 192 : TL); }
        const int nt = ctxq ? 4 : 4 + ((hi - lo) >> 6);
        bf16x8 qf[2][NKK];
#pragma unroll
        for (int q = 0; q < 2; ++q)
#pragma unroll
            for (int kk = 0; kk < NKK; ++kk)
                qf[q][kk] = *(const bf16x8*)(Q + (size_t)(row0 + wrow + 16 * q + l16) * ldq + h * DQK + kk * 32 + g * 8);
        f32x4 oacc[8][2];
#pragma unroll
        for (int d = 0; d < 8; ++d) { oacc[d][0] = (f32x4){0.f, 0.f, 0.f, 0.f}; oacc[d][1] = (f32x4){0.f, 0.f, 0.f, 0.f}; }
        float mrun[2], lrun[2];
        if (sinks) { const float s = sinks[h] * LOG2E; mrun[0] = mrun[1] = s; lrun[0] = lrun[1] = (g == 0) ? 1.f : 0.f; }
        else { mrun[0] = mrun[1] = -INFINITY; lrun[0] = lrun[1] = 0.f; }
        u32x4 rk[NKC], rv[2];
        const bf16_t* KnH = Kn + hk * 128;
        const bf16_t* VTH = VT + (size_t)hk * 128 * NT;
        auto prefetch_k = [&](int j) __attribute__((always_inline)) {
            const int t_ = tid_(), kr_ = t_ >> 3, kc_ = t_ & 7;
            const int k0 = j < 4 ? j * 64 : lo + (j - 4) * 64;
            const bf16_t* kb_ = KnH + (size_t)k0 * ldk + kr_ * ldk + kc_ * 8;
#pragma unroll
            for (int i = 0; i < 2; ++i) rk[i] = *(const u32x4*)(kb_ + i * 64);
            if (DQK > 128) rk[NKC - 1] = *(const u32x4*)(KR + (size_t)k0 * 64 + kr_ * 64 + kc_ * 8);
        };
        auto prefetch_v = [&](int j) __attribute__((always_inline)) {
            const int t_ = tid_(), vr_ = t_ >> 2, vc_ = (t_ & 3) * 2;
            const int k0 = j < 4 ? j * 64 : lo + (j - 4) * 64;
            const bf16_t* vb_ = VTH + k0 + vr_ * NT + vc_ * 8;
#pragma unroll
            for (int i = 0; i < 2; ++i) rv[i] = *(const u32x4*)(vb_ + i * 8);
        };
        auto write_kv = [&](int j) __attribute__((always_inline)) {
            const int t_ = tid_(), kr_ = t_ >> 3, kc_ = t_ & 7, vr_ = t_ >> 2, vc_ = (t_ & 3) * 2;
            char* kd = Ks0 + (j & 1) * KBUF + kr_ * KSTR + kc_ * 16;
            char* vd = Vs0 + (j & 1) * VBUF + vr_ * VSTR + vc_ * 16;
#pragma unroll
            for (int i = 0; i < NKC; ++i) *(u32x4*)(kd + i * 128) = rk[i];
#pragma unroll
            for (int i = 0; i < 2; ++i) *(u32x4*)(vd + i * 16) = rv[i];
        };
        __syncthreads();
        prefetch_k(0); prefetch_v(0); write_kv(0);
        prefetch_k(1); prefetch_v(1);
        for (int j = 0; j < nt; ++j) {
            __syncthreads();
            if (j + 1 < nt) write_kv(j + 1);
            if (j + 2 < nt) prefetch_k(j + 2);
            const char* Ks = Ks0 + (j & 1) * KBUF;
            const char* Vs = Vs0 + (j & 1) * VBUF;
            const int k0 = j < 4 ? j * 64 : lo + (j - 4) * 64;
            if (WINDOW && j >= 4) {
                const int q0 = row0 + wrow;
#if 1
                if (k0 > q0 + 31 + 128 || k0 + 63 < q0 - 128) { if (j + 2 < nt) prefetch_v(j + 2); continue; }
#endif
            }
            f32x4 sacc[4][2];
#pragma unroll
            for (int kb = 0; kb < 4; ++kb) { sacc[kb][0] = (f32x4){0.f, 0.f, 0.f, 0.f}; sacc[kb][1] = (f32x4){0.f, 0.f, 0.f, 0.f}; }
#pragma unroll
            for (int kk = 0; kk < NKK; ++kk) {
#pragma unroll
                for (int kb = 0; kb < 4; ++kb) {
                    const bf16x8 kf = *(const bf16x8*)(Ks + (16 * kb + l16) * KSTR + kk * 64 + g * 16);
                    sacc[kb][0] = __builtin_amdgcn_mfma_f32_16x16x32_bf16(kf, qf[0][kk], sacc[kb][0], 0, 0, 0);
                    sacc[kb][1] = __builtin_amdgcn_mfma_f32_16x16x32_bf16(kf, qf[1][kk], sacc[kb][1], 0, 0, 0);
                }
            }
            if (WINDOW && j >= 4) {
#pragma unroll
                for (int q = 0; q < 2; ++q) {
                    const int qp = row0 + wrow + 16 * q + l16;
#pragma unroll
                    for (int kb = 0; kb < 4; ++kb)
#pragma unroll
                        for (int i = 0; i < 4; ++i) {
                            const int d = k0 + 16 * kb + 4 * g + i - qp;
                            if (d > 128 || d < -128) sacc[kb][q][i] = -INFINITY;
                        }
                }
            }
            auto ldv = [&](int kg, int d) __attribute__((always_inline)) {
                return *(const bf16x8*)(Vs + (16 * d + l16) * VSTR + kg * 64 + g * 16);
            };
            if (j + 2 < nt) prefetch_v(j + 2);
            bf16x8 vfa[4], vfb[4];
#pragma unroll
            for (int d = 0; d < 4; ++d) vfa[d] = ldv(0, d);
            bf16x8 pf[2][2];
#pragma unroll
            for (int q = 0; q < 2; ++q) {
                float mx = -INFINITY;
#pragma unroll
                for (int kb = 0; kb < 4; ++kb) mx = fmaxf(mx, fmaxf(fmaxf(sacc[kb][q][0], sacc[kb][q][1]), fmaxf(sacc[kb][q][2], sacc[kb][q][3])));
                mx = xmax16_32(mx);
                const float mnew = fmaxf(mrun[q], mx);
                const float alpha = fast_exp2(mrun[q] - mnew);
                mrun[q] = mnew;
                float ps = 0.f;
                unsigned pw[8];
#pragma unroll
                for (int kb = 0; kb < 4; ++kb) {
                    const float p0 = fast_exp2(sacc[kb][q][0] - mnew), p1 = fast_exp2(sacc[kb][q][1] - mnew), p2 = fast_exp2(sacc[kb][q][2] - mnew), p3 = fast_exp2(sacc[kb][q][3] - mnew);
                    ps += (p0 + p1) + (p2 + p3);
                    pw[kb * 2] = cvt_pk(p0, p1); pw[kb * 2 + 1] = cvt_pk(p2, p3);
                }
                lrun[q] = lrun[q] * alpha + ps;
                u32x4 t0 = (u32x4){pw[0], pw[1], pw[2], pw[3]}, t1 = (u32x4){pw[4], pw[5], pw[6], pw[7]};
                pf[q][0] = __builtin_bit_cast(bf16x8, t0); pf[q][1] = __builtin_bit_cast(bf16x8, t1);
                if (__builtin_amdgcn_ballot_w64(alpha != 1.0f) != 0ull) {
#pragma unroll
                    for (int d = 0; d < 8; ++d) oacc[d][q] *= alpha;
                }
            }
#pragma unroll
            for (int d = 0; d < 4; ++d) {
                oacc[d][0] = __builtin_amdgcn_mfma_f32_16x16x32_bf16(vfa[d], pf[0][0], oacc[d][0], 0, 0, 0);
                oacc[d][1] = __builtin_amdgcn_mfma_f32_16x16x32_bf16(vfa[d], pf[1][0], oacc[d][1], 0, 0, 0);
                vfb[d] = ldv(0, d + 4);
            }
#pragma unroll
            for (int d = 0; d < 4; ++d) {
                oacc[d + 4][0] = __builtin_amdgcn_mfma_f32_16x16x32_bf16(vfb[d], pf[0][0], oacc[d + 4][0], 0, 0, 0);
                oacc[d + 4][1] = __builtin_amdgcn_mfma_f32_16x16x32_bf16(vfb[d], pf[1][0], oacc[d + 4][1], 0, 0, 0);
                vfa[d] = ldv(1, d);
            }
#pragma unroll
            for (int d = 0; d < 4; ++d) {
                oacc[d][0] = __builtin_amdgcn_mfma_f32_16x16x32_bf16(vfa[d], pf[0][1], oacc[d][0], 0, 0, 0);
                oacc[d][1] = __builtin_amdgcn_mfma_f32_16x16x32_bf16(vfa[d], pf[1][1], oacc[d][1], 0, 0, 0);
                vfb[d] = ldv(1, d + 4);
            }
#pragma unroll
            for (int d = 0; d < 4; ++d) {
                oacc[d + 4][0] = __builtin_amdgcn_mfma_f32_16x16x32_bf16(vfb[d], pf[0][1], oacc[d + 4][0], 0, 0, 0);
                oacc[d + 4][1] = __builtin_amdgcn_mfma_f32_16x16x32_bf16(vfb[d], pf[1][1], oacc[d + 4][1], 0, 0, 0);
            }
        }
#pragma unroll
        for (int q = 0; q < 2; ++q) {
            float l = lrun[q];
            l += __shfl_xor(l, 16); l += __shfl_xor(l, 32);
            const float inv = 1.0f / l;
            const int row = row0 + wrow + 16 * q + l16;
#pragma unroll
            for (int d = 0; d < 8; ++d) *(u32x2*)(O + (size_t)row * 1024 + h * 128 + 16 * d + 4 * g) = pack4(oacc[d][q] * inv);
        }
    }
    __syncthreads();
}

__device__ __forceinline__ void rownorm_phase(const Params& p, int mode, const float* gpost, int gate_idx, int mod_layer_post,
                                              const float* gpre, int shift_idx, int scale_idx, int mod_layer_pre, bool x_in = false) {
    const int tid0 = tid_(); const int lane = tid0 & 63, wv = tid0 >> 6;
    const int gw = blockIdx.x * 8 + wv, nw = gridDim.x * 8;
    float* XC = (float*)(p.ws + OFF_XC);
    const bf16_t* Y = (const bf16_t*)(p.ws + OFF_Y);
    bf16_t* H = (bf16_t*)(p.ws + OFF_H);
    const float* MOD = (const float*)(p.ws + OFF_MOD);
    for (int row = gw; row < NT; row += nw) {
        const int isctx = row < NCTX ? 1 : 0;
        float* xr = isctx ? XC + (size_t)row * 1024 : p.out + (size_t)(row - NCTX) * 1024;
        f32x4 x[4];
        const float* xsrc = isctx ? p.in[2] + (size_t)row * 1024 : p.in[0] + (size_t)(row - NCTX) * 1024;
        if (mode == 0) {
#pragma unroll
            for (int j = 0; j < 4; ++j) x[j] = *(const f32x4*)(xsrc + j * 256 + lane * 4);
        } else {
            f32x4 y[4];
            float ss = 0.f;
#pragma unroll
            for (int j = 0; j < 4; ++j) {
                { const u32x2 yw = *(const u32x2*)(Y + (size_t)row * 1024 + j * 256 + lane * 4); y[j] = (f32x4){bflo(yw.x), bfhi(yw.x), bflo(yw.y), bfhi(yw.y)}; }
                x[j] = *(const f32x4*)((x_in ? xsrc : xr) + j * 256 + lane * 4);
                ss += y[j][0] * y[j][0] + y[j][1] * y[j][1] + y[j][2] * y[j][2] + y[j][3] * y[j][3];
            }
            ss = wave_sum(ss);
            const float rinv = rsqrtf(ss * (1.0f / 1024.0f) + RMS_EPS);
            const float* gate = MOD + ((size_t)(mod_layer_post * 2 + isctx) * 6 + gate_idx) * 1024;
#pragma unroll
            for (int j = 0; j < 4; ++j) {
                const f32x4 gp = *(const f32x4*)(gpost + j * 256 + lane * 4);
                const f32x4 gt = *(const f32x4*)(gate + j * 256 + lane * 4);
                x[j] = x[j] + gt * (y[j] * rinv * gp);
            }
        }
        if (mode != 0) {
#pragma unroll
            for (int j = 0; j < 4; ++j) *(f32x4*)(xr + j * 256 + lane * 4) = x[j];
        }
        if (gpre) {
            float ss = 0.f;
#pragma unroll
            for (int j = 0; j < 4; ++j) ss += x[j][0] * x[j][0] + x[j][1] * x[j][1] + x[j][2] * x[j][2] + x[j][3] * x[j][3];
            ss = wave_sum(ss);
            const float rinv = rsqrtf(ss * (1.0f / 1024.0f) + RMS_EPS);
            const float* shift = MOD + ((size_t)(mod_layer_pre * 2 + isctx) * 6 + shift_idx) * 1024;
            const float* scale = MOD + ((size_t)(mod_layer_pre * 2 + isctx) * 6 + scale_idx) * 1024;
#pragma unroll
            for (int j = 0; j < 4; ++j) {
                const f32x4 gp = *(const f32x4*)(gpre + j * 256 + lane * 4);
                const f32x4 sh = *(const f32x4*)(shift + j * 256 + lane * 4);
                const f32x4 sc = *(const f32x4*)(scale + j * 256 + lane * 4);
                const f32x4 hv = (x[j] * rinv * gp) * (sc + 1.0f) + sh;
                *(u32x2*)(H + (size_t)row * 1024 + j * 256 + lane * 4) = pack4(hv);
            }
        }
    }
}

__device__ __forceinline__ int colmap(int mode, int n) {
    if (mode == 1) { const int G = n >> 5, w = n & 31; return w < 16 ? G * 16 + w : FH + G * 16 + (w - 16); }
    if (mode == 2) return n < 832 ? n : -1;
    if (mode == 3) { const int hh = (n & 1023) >> 7, d = n & 127; return hh * 256 + d + (n >= 1024 ? 128 : 0); }
    if (mode == 5) {
        if (n >= 1280) return n;
        const int head = n >> 7, cq = n & 127, q = cq >> 5, half = (cq >> 4) & 1, f16 = cq & 15;
        return head * 128 + (q >> 1) * 64 + half * 32 + (q & 1) * 16 + f16;
    }
    return n;
}
__device__ __forceinline__ void sincos_d(float ang, float& c, float& s) {
    const double a = (double)ang;
    const double k = rint(a * 0.63661977236758134308);
    const double r = a - k * 1.57079632679489661923;
    const double r2 = r * r;
    const double sp = r * (1.0 + r2 * (-1.0 / 6 + r2 * (1.0 / 120 + r2 * (-1.0 / 5040 + r2 * (1.0 / 362880 + r2 * (-1.0 / 39916800 + r2 * (1.0 / 6227020800.0)))))));
    const double cp = 1.0 + r2 * (-0.5 + r2 * (1.0 / 24 + r2 * (-1.0 / 720 + r2 * (1.0 / 40320 + r2 * (-1.0 / 3628800 + r2 * (1.0 / 479001600.0 + r2 * (-1.0 / 87178291200.0)))))));
    const int q = ((int)k) & 3;
    double cc, sn;
    if (q == 0) { cc = cp; sn = sp; } else if (q == 1) { cc = -sp; sn = cp; } else if (q == 2) { cc = -cp; sn = -sp; } else { cc = sp; sn = -cp; }
    c = (float)cc; s = (float)sn;
}

__device__ __forceinline__ void prologue_phase(const Params& p, char* smem) {
    const int tid = tid_();
    float* tile = (float*)smem;
#ifndef PRO_DUP
#define PRO_DUP 0
#endif
    for (int rep_ = 0; rep_ < (PRO_DUP == 2 ? 2 : 1); ++rep_)
    for (int task = blockIdx.x; task < 388; task += gridDim.x) {
        if (false) {
        } else if (task < 384) {
            const int mt = task, layer = mt / 96, n0 = (mt % 96) * 64;
            float* sl = (float*)smem;
            float* sx = sl + 1024;
            f32x4* red = (f32x4*)(sx + 1024);
            for (int k = tid; k < 1024; k += 512) { sl[k] = siluf_(p.in[1][k]); sx[k] = siluf_(p.in[3][k]); }
            __syncthreads();
            const int j4 = (tid & 15) * 4, kq = tid >> 4;
            const float* w = p.in[4] + (size_t)layer * 1024 * 6144 + n0 + j4;
            f32x4 al = (f32x4){0.f, 0.f, 0.f, 0.f}, ac = al;
#pragma unroll 16
            for (int k = kq * 32; k < kq * 32 + 32; ++k) { const f32x4 wv = *(const f32x4*)(w + (size_t)k * 6144); al += wv * sl[k]; ac += wv * sx[k]; }
            red[kq * 16 + (tid & 15)] = al; red[512 + kq * 16 + (tid & 15)] = ac;
            __syncthreads();
            if (tid < 32) {
                const int which = tid >> 4, jj = tid & 15;
                f32x4 sum = (f32x4){0.f, 0.f, 0.f, 0.f};
#pragma unroll 8
                for (int q = 0; q < 32; ++q) sum += red[which * 512 + q * 16 + jj];
                float* MOD = (float*)(p.ws + OFF_MOD);
                const f32x4 bb = *(const f32x4*)(p.in[5] + layer * 6144 + n0 + jj * 4);
                *(f32x4*)(MOD + (size_t)(layer * 2 + which) * 6144 + n0 + jj * 4) = sum + bb;
            }
            __syncthreads();
        } else {
            const int st = task - 384;
            if (st == 0) {
                float* cosT = (float*)(p.ws + OFF_ROPEA); float* sinT = cosT + 256 * 32;
                for (int e = tid; e < 256 * 32; e += 512) {
                    const int pos = e >> 5, f = e & 31;
                    const float pw = (float)pow(10000.0, (double)((float)(2 * f) / 64.0f));
                    const float inv = 1.0f / pw;
                    float c, s; sincos_d((float)pos * inv, c, s);
                    cosT[e] = c; sinT[e] = s;
                }
            } else if (st == 1) {
                float* cosT = (float*)(p.ws + OFF_ROPEC); float* sinT = cosT + 256 * 16;
                for (int e = tid; e < 256 * 16; e += 512) {
                    const int pos = e >> 4, f = e & 15;
                    const float pw = (float)pow(10000.0, (double)((float)(2 * f) / 32.0f));
                    const float inv = 1.0f / pw;
                    float c, s; sincos_d((float)pos * inv, c, s);
                    cosT[e] = c; sinT[e] = s;
                }
            } else if (st == 2) {
                float* gb = (float*)(p.ws + OFF_GBIAS);
                for (int n = tid; n < 4096; n += 512) {
                    const int dir = n >> 11, ch = (n & 2047) >> 1, gate = n & 1;
                    gb[n] = gate ? p.in[19][dir * 1024 + ch] : p.in[17][dir * 1024 + ch];
                }
            } else {
                float* ss = (float*)(p.ws + OFF_SS);
                for (int e = tid; e < NT * 2; e += 512) ss[e] = 0.f;
            }
        }
    }
    {
        constexpr int TS = 133;
        const int j4 = (tid & 31) * 4, kq = tid >> 5;
        const int jw = tid >> 4, kg = (tid & 15) * 8;
        f32x4 cur[2][8], nxt[2][8];
        ConvJob jb[2], jbn[2];
        int n0[2] = {0, 0}, k0[2] = {0, 0}, n0n[2] = {0, 0}, k0n[2] = {0, 0};
        auto locate = [&](int ct, ConvJob& J, int& N0, int& K0) __attribute__((always_inline)) {
            int ji = 0;
#pragma unroll 1
            for (int q = 1; q < NJOBS; ++q) if (ct >= p.jobs[q].tile0) ji = q;
            J = p.jobs[ji];
            const int lt = ct - J.tile0, tk = J.K >> 7;
            const int tni = lt / tk, tki = lt - tni * tk;
            N0 = tni * 128; K0 = tki * 128;
        };
        auto fetch = [&](const ConvJob& J, int N0, int K0, f32x4 (&v)[8]) __attribute__((always_inline)) {
            const int sc = colmap(J.mode, N0 + j4);
#pragma unroll
            for (int i = 0; i < 8; ++i) {
                const int kk = kq + 16 * i;
                v[i] = (f32x4){0.f, 0.f, 0.f, 0.f};
                if (sc >= 0) { v[i] = *(const f32x4*)(J.src + (size_t)(K0 + kk) * J.ld + sc); if (J.kscale) v[i] *= J.kscale[K0 + kk]; }
            }
        };
        const int G = gridDim.x, T = p.conv_tiles;
        int ct = blockIdx.x;
#pragma unroll
        for (int h = 0; h < 2; ++h) if (ct + h * G < T) { locate(ct + h * G, jb[h], n0[h], k0[h]); fetch(jb[h], n0[h], k0[h], cur[h]); }
        for (; ct < T; ct += 2 * G) {
#pragma unroll
            for (int h = 0; h < 2; ++h) if (ct + (2 + h) * G < T) { locate(ct + (2 + h) * G, jbn[h], n0n[h], k0n[h]); fetch(jbn[h], n0n[h], k0n[h], nxt[h]); }
#pragma unroll
            for (int h = 0; h < 2; ++h) {
                if (ct + h * G < T) {
#pragma unroll
                    for (int i = 0; i < 8; ++i) { float* tp = tile + (kq + 16 * i) * TS + j4; tp[0] = cur[h][i][0]; tp[1] = cur[h][i][1]; tp[2] = cur[h][i][2]; tp[3] = cur[h][i][3]; }
                    __syncthreads();
#pragma unroll
                    for (int ii = 0; ii < 4; ++ii) {
                        const int j = jw + 32 * ii;
                        float v[8];
#pragma unroll
                        for (int i = 0; i < 8; ++i) v[i] = tile[(kg + i) * TS + j];
                        u32x4 w; w.x = cvt_pk(v[0], v[1]); w.y = cvt_pk(v[2], v[3]); w.z = cvt_pk(v[4], v[5]); w.w = cvt_pk(v[6], v[7]);
                        *(u32x4*)(jb[h].dst + (size_t)(jb[h].roff + (n0[h] + j) * jb[h].rmul) * jb[h].K + k0[h] + kg) = w;
                    }
                    __syncthreads();
                }
            }
#pragma unroll
            for (int h = 0; h < 2; ++h) {
                jb[h] = jbn[h]; n0[h] = n0n[h]; k0[h] = k0n[h];
#pragma unroll
                for (int i = 0; i < 8; ++i) cur[h][i] = nxt[h][i];
            }
        }
    }
    __syncthreads();
}

__device__ __forceinline__ void conv_phase(const Params& p) {
    const bf16_t* ZX = (const bf16_t*)(p.ws + OFF_ZX);
    bf16_t* XB = (bf16_t*)(p.ws + OFF_H);
    const float* cw = p.in[13]; const float* cb = p.in[14];
    const int total = NT * 128;
    for (int e = blockIdx.x * 512 + tid_(); e < total; e += gridDim.x * 512) {
        const int row = e >> 7, c8 = (e & 127) * 8;
        const int seg_lo = row < NCTX ? 0 : NCTX, seg_hi = row < NCTX ? NCTX : NT;
        float acc[8];
#pragma unroll
        for (int i = 0; i < 8; ++i) acc[i] = cb[c8 + i];
#pragma unroll
        for (int k = 0; k < 4; ++k) {
            const int r = row + k - 1;
            if (r >= seg_lo && r < seg_hi) {
                const u32x4 z = *(const u32x4*)(ZX + (size_t)r * 1024 + c8);
                const f32x4 w0 = *(const f32x4*)(cw + k * 1024 + c8), w1 = *(const f32x4*)(cw + k * 1024 + c8 + 4);
                acc[0] += w0[0] * bflo(z.x); acc[1] += w0[1] * bfhi(z.x); acc[2] += w0[2] * bflo(z.y); acc[3] += w0[3] * bfhi(z.y);
                acc[4] += w1[0] * bflo(z.z); acc[5] += w1[1] * bfhi(z.z); acc[6] += w1[2] * bflo(z.w); acc[7] += w1[3] * bfhi(z.w);
            }
        }
        u32x4 o; o.x = cvt_pk(acc[0], acc[1]); o.y = cvt_pk(acc[2], acc[3]); o.z = cvt_pk(acc[4], acc[5]); o.w = cvt_pk(acc[6], acc[7]);
        *(u32x4*)(XB + (size_t)row * 1024 + c8) = o;
    }
}
__device__ __forceinline__ void scan_coef(unsigned ri, float u, float c8, float& a, float& b) {
    const float r = bflo(ri), i = bfhi(ri);
    const float la = -c8 * r;
    a = __expf(la);
    b = sqrtf(-expm1f(2.0f * la)) * (i * u);
}
__device__ __forceinline__ float lam_c8(const float* lam, int dir, int ch) {
    const float l = lam[dir * 1024 + ch];
    return 8.0f * (l > 0.f ? log1pf(__expf(-l)) : (-l + log1pf(__expf(l))));
}

__device__ __forceinline__ void scan1_phase(const Params& p) {
    const unsigned* GT = (const unsigned*)(p.ws + OFF_BIG + BB_GATES);
    const bf16_t* XB = (const bf16_t*)(p.ws + OFF_H);
    float* SA = (float*)(p.ws + OFF_SCAN); float* SB = SA + 2 * NRB * 1024;
    const int tid = tid_();
    for (int task = blockIdx.x; task < NRB * 2 * 2; task += gridDim.x) {
        const int rc = task >> 2, dir = (task >> 1) & 1, ch = (task & 1) * 512 + tid;
        const float c8 = lam_c8(p.in[15], dir, ch);
        float h = 0.f, P = 1.f;
#pragma unroll 8
        for (int s = 0; s < 128; ++s) {
            const int row = rc * 128 + (dir ? 127 - s : s);
            const unsigned ri = GT[(size_t)row * 2048 + dir * 1024 + ch];
            const float u = bf2f(XB[(size_t)row * 1024 + ch]);
            float a, b; scan_coef(ri, u, c8, a, b);
            h = a * h + b; P *= a;
        }
        SA[(size_t)(dir * NRB + rc) * 1024 + ch] = P;
        SB[(size_t)(dir * NRB + rc) * 1024 + ch] = h;
    }
}
__device__ __forceinline__ void scan3_phase(const Params& p) {
    unsigned* GT = (unsigned*)(p.ws + OFF_BIG + BB_GATES);
    const bf16_t* XB = (const bf16_t*)(p.ws + OFF_H);
    const bf16_t* G = (const bf16_t*)(p.ws + OFF_Y);
    bf16_t* HG = (bf16_t*)(p.ws + OFF_H);
    const float* SA = (const float*)(p.ws + OFF_SCAN); const float* SB = SA + 2 * NRB * 1024;
    const int tid = tid_();
    const int wv = tid >> 6, lane = tid & 63;
    for (int task = blockIdx.x * 8 + wv; task < NRB * 16; task += gridDim.x * 8) {
        const int rc = task >> 4, ch = (task & 15) * 64 + lane;
        {
            const float c8 = lam_c8(p.in[15], 0, ch);
            float h = 0.f;
#pragma unroll 8
            for (int j = 0; j < rc; ++j) h = SA[(size_t)j * 1024 + ch] * h + SB[(size_t)j * 1024 + ch];
#pragma unroll 8
            for (int s = 0; s < 128; ++s) {
                const int row = rc * 128 + s;
                const unsigned ri = GT[(size_t)row * 2048 + ch];
                const float u = bf2f(XB[(size_t)row * 1024 + ch]);
                float a, b; scan_coef(ri, u, c8, a, b);
                h = a * h + b;
                GT[(size_t)row * 2048 + ch] = __float_as_uint(h);
            }
        }
        {
            const float c8 = lam_c8(p.in[15], 1, ch);
            const float* SA1 = SA + (size_t)NRB * 1024; const float* SB1 = SB + (size_t)NRB * 1024;
            float h = 0.f;
            if (rc == 0) { h = SB1[(size_t)1 * 1024 + ch]; }
            else if (rc >= 2) {
                h = SB1[(size_t)1 * 1024 + ch];
                h = SA1[ch] * h + SB1[ch];
#pragma unroll 8
                for (int j = NRB - 1; j > rc; --j) h = SA1[(size_t)j * 1024 + ch] * h + SB1[(size_t)j * 1024 + ch];
            }
#pragma unroll 8
            for (int s = 0; s < 128; ++s) {
                const int row = rc * 128 + 127 - s;
                const unsigned ri = GT[(size_t)row * 2048 + 1024 + ch];
                const float u = bf2f(XB[(size_t)row * 1024 + ch]);
                float a, b; scan_coef(ri, u, c8, a, b);
                h = a * h + b;
                const float hf = __uint_as_float(GT[(size_t)row * 2048 + ch]);
                const float o = (hf + h) * bf2f(G[(size_t)row * 1024 + ch]);
                HG[(size_t)row * 1024 + ch] = (bf16_t)(cvt_pk(o, 0.f) & 0xffff);
            }
        }
    }
}

constexpr int NPHASES = 34;
__device__ __forceinline__ void ffn_gu(const Params& p, int l, char* smem) {
    EpiGU e{(bf16_t*)(p.ws + OFF_BIG)};
    gemm(smem, (const bf16_t*)(p.ws + OFF_H), 1024, (const bf16_t*)(p.ws + OFF_WB) + wo_gu(l), NT, 5632, 1024, 0, 0, e);
}
__device__ __forceinline__ void ffn_dn(const Params& p, int l, char* smem) {
    const bf16_t* A = (const bf16_t*)(p.ws + OFF_BIG); const bf16_t* W = (const bf16_t*)(p.ws + OFF_WB) + wo_dn(l);
    bf16_t* Y = (bf16_t*)(p.ws + OFF_Y);
    ctx_gemm_f32(smem, A, FH, W, FH, Y);
    EpiF32 e{Y + (size_t)NCTX * 1024, 1024};
    gemm<EpiF32, false>(smem, A + (size_t)NCTX * FH, FH, W, TL, 1024, FH, 0, 0, e);
}
__device__ __forceinline__ void proj_out(const Params& p, const bf16_t* A, size_t woff, char* smem) {
    const bf16_t* W = (const bf16_t*)(p.ws + OFF_WB) + woff;
    bf16_t* Y = (bf16_t*)(p.ws + OFF_Y);
    ctx_gemm_f32(smem, A, 1024, W, 1024, Y);
    EpiF32 e{Y + (size_t)NCTX * 1024, 1024};
    gemm<EpiF32, false>(smem, A + (size_t)NCTX * 1024, 1024, W, TL, 1024, 1024, 0, 0, e);
}
__device__ __forceinline__ void r1(const Params& p, int l) {
    const float* ng = p.in[6] + (size_t)l * 4 * 1024;
    rownorm_phase(p, 1, ng + 1024, 2, l, ng + 2048, 3, 4, l, l == 0);
}
__device__ __forceinline__ void r2(const Params& p, int l) {
    const float* ng = p.in[6] + (size_t)l * 4 * 1024;
    if (l < 3) rownorm_phase(p, 1, ng + 3072, 5, l, ng + 4096, 0, 1, l + 1);
    else rownorm_phase(p, 1, ng + 3072, 5, l, nullptr, 0, 0, 0);
}
__device__ __forceinline__ void layerA_qkv(const Params& p, int j, char* smem) {
    const bf16_t* H = (const bf16_t*)(p.ws + OFF_H);
    const bf16_t* W = (const bf16_t*)(p.ws + OFF_WB) + wo_aqkv(j);
    const float* cosT = (const float*)(p.ws + OFF_ROPEA);
    EpiQK e{(bf16_t*)(p.ws + OFF_BIG + BA_Q), (bf16_t*)(p.ws + OFF_BIG + BA_K), (bf16_t*)(p.ws + OFF_BIG + BA_VT), cosT, cosT + 256 * 32, 0.08838834764831845f * LOG2E};
    gemm(smem, H, 1024, W, NT, 1536, 1024, 0, 0, e);
}
__device__ __forceinline__ void layerA_attn(const Params& p, int j, char* smem) {
    attn_run<128, true>((const bf16_t*)(p.ws + OFF_BIG + BA_Q), 1024, (const bf16_t*)(p.ws + OFF_BIG + BA_K), 256, 4, nullptr,
                        (const bf16_t*)(p.ws + OFF_BIG + BA_VT), (bf16_t*)(p.ws + OFF_H), p.in[10] + j * 8, smem);
}

__device__ __forceinline__ void run_phase(const Params& p, int ph, char* smem) {
    const bf16_t* WB = (const bf16_t*)(p.ws + OFF_WB);
    const bf16_t* H = (const bf16_t*)(p.ws + OFF_H);
    switch (ph) {
    case 0: prologue_phase(p, smem); break;
    case 1: rownorm_phase(p, 0, nullptr, 0, 0, p.in[6], 0, 1, 0); break;
    case 2: layerA_qkv(p, 0, smem); break;
    case 3: layerA_attn(p, 0, smem); break;
    case 4: proj_out(p, H, wo_ao(0), smem); break;
    case 5: r1(p, 0); break;
    case 6: ffn_gu(p, 0, smem); break;
    case 7: ffn_dn(p, 0, smem); break;
    case 8: r2(p, 0); break;
    case 9: { EpiBin e{(bf16_t*)(p.ws + OFF_ZX), (bf16_t*)(p.ws + OFF_Y)}; gemm(smem, H, 1024, WB + WO_BIN, NT, 2048, 1024, 0, 0, e); } break;
    case 10: conv_phase(p); break;
    case 11: { EpiGates e{(bf16_t*)(p.ws + OFF_BIG + BB_GATES), (const float*)(p.ws + OFF_GBIAS)}; gemm(smem, H, 1024, WB + WO_BG, NT, 4096, 256, 1, 0, e); } break;
    case 12: scan1_phase(p); break;
    case 13: scan3_phase(p); break;
    case 14: proj_out(p, H, WO_BOUT, smem); break;
    case 15: r1(p, 1); break;
    case 16: ffn_gu(p, 1, smem); break;
    case 17: ffn_dn(p, 1, smem); break;
    case 18: r2(p, 1); break;
    case 19: { const float* cosT = (const float*)(p.ws + OFF_ROPEC);
               EpiCin e{(bf16_t*)(p.ws + OFF_ZQ), (bf16_t*)(p.ws + OFF_ZKV), (bf16_t*)(p.ws + OFF_KR), (float*)(p.ws + OFF_SS), cosT, cosT + 256 * 16};
               gemm(smem, H, 1024, WB + WO_CIN, NT, 1024, 1024, 0, 0, e); } break;
    case 20: { const float* cosT = (const float*)(p.ws + OFF_ROPEC); const float* ss = (const float*)(p.ws + OFF_SS);
               const bf16_t* ZQ = (const bf16_t*)(p.ws + OFF_ZQ); const bf16_t* ZKV = (const bf16_t*)(p.ws + OFF_ZKV);
               EpiQc eq{(bf16_t*)(p.ws + OFF_BIG + BC_QC), ss, cosT, cosT + 256 * 16, 0.07216878364870322f * LOG2E};
               gemm(smem, ZQ, 512, WB + WO_CUQ, NT, 1536, 512, 0, 0, eq);
               EpiKn ek{(bf16_t*)(p.ws + OFF_BIG + BC_KN), ss};
               gemm(smem, ZKV, 256, WB + WO_CUKV, NT, 1024, 256, 0, 390 % 256, ek);
               EpiVT ev{(bf16_t*)(p.ws + OFF_BIG + BC_VT), ss, 1, 1.0f / 256.0f};
               gemm(smem, WB + WO_CUKV + (size_t)1024 * 256, 256, ZKV, 1024, NT, 256, 0, (390 + 260) % 256, ev); } break;
    case 21: attn_run<192, false>((const bf16_t*)(p.ws + OFF_BIG + BC_QC), 1536, (const bf16_t*)(p.ws + OFF_BIG + BC_KN), 1024, 1,
                                  (const bf16_t*)(p.ws + OFF_KR), (const bf16_t*)(p.ws + OFF_BIG + BC_VT), (bf16_t*)(p.ws + OFF_H), nullptr, smem); break;
    case 22: proj_out(p, H, WO_COUT, smem); break;
    case 23: r1(p, 2); break;
    case 24: ffn_gu(p, 2, smem); break;
    case 25: ffn_dn(p, 2, smem); break;
    case 26: r2(p, 2); break;
    case 27: layerA_qkv(p, 1, smem); break;
    case 28: layerA_attn(p, 1, smem); break;
    case 29: proj_out(p, H, wo_ao(1), smem); break;
    case 30: r1(p, 3); break;
    case 31: ffn_gu(p, 3, smem); break;
    case 32: ffn_dn(p, 3, smem); break;
    case 33: r2(p, 3); break;
    default: break;
    }
}

#define XB_TMO      128
#define XB_XCNT(j)  (256  + 64 * (j))
#define XB_XSUB(j)  (1280 + 64 * (j))
#define XB_XGEN(j)  (2304 + 64 * (j))
#define XB_TOP      3328
#define XB_TOPGEN   3392
#define XCD_BAR_WORDS 3456
#define XB_SPIN_CAP (1u << 20)
#define LAS __attribute__((address_space(3)))
__device__ __forceinline__ unsigned xb_ld(unsigned* p)              { return __hip_atomic_load(p, __ATOMIC_RELAXED, __HIP_MEMORY_SCOPE_AGENT); }
__device__ __forceinline__ unsigned xb_add(unsigned* p, unsigned v) { return __hip_atomic_fetch_add(p, v, __ATOMIC_RELAXED, __HIP_MEMORY_SCOPE_AGENT); }
__device__ __forceinline__ unsigned xb_xcc_id() { return (unsigned)__builtin_amdgcn_s_getreg((3 << 11) | 20) & 0xFu; }
#define XB_SPIN(cond, bar) do { unsigned _sp = 0; while (cond) { __builtin_amdgcn_s_sleep(1); \
    if ((++_sp & 255u) == 0u) { if (xb_ld(&(bar)[XB_TMO])) break; if (_sp > XB_SPIN_CAP) { atomicAdd(&(bar)[XB_TMO], 1u); break; } } } } while (0)
struct XcdBarrier { unsigned* bar; unsigned x; volatile LAS unsigned* st; };
__device__ __forceinline__ XcdBarrier xcd_barrier_post(unsigned* bar, volatile LAS unsigned* st) {
    XcdBarrier b; b.bar = bar; b.x = xb_xcc_id(); b.st = st;
    if (threadIdx.x == 0) (void)xb_add(&bar[XB_XCNT(b.x)], 1u);
    return b;
}
__device__ __forceinline__ void xcd_barrier_complete(unsigned* bar, unsigned x, unsigned& nloc, unsigned& nx) {
    const unsigned G = gridDim.x * gridDim.y * gridDim.z;
    unsigned sum, cnt, mine, sp = 0u;
    for (;;) {
        sum = 0u; cnt = 0u; mine = 0u;
#pragma unroll
        for (unsigned j = 0; j < 16; ++j) { const unsigned c = xb_ld(&bar[XB_XCNT(j)]); sum += c; cnt += (c > 0u) ? 1u : 0u; mine = (j == x) ? c : mine; }
        if (sum == G) break;
        __builtin_amdgcn_s_sleep(1);
        if ((++sp & 255u) == 0u) { if (xb_ld(&bar[XB_TMO])) break; if (sp > XB_SPIN_CAP) { atomicAdd(&bar[XB_TMO], 1u); break; } }
    }
    nloc = mine > 0u ? mine : 1u; nx = cnt > 0u ? cnt : 1u;
}
__device__ __forceinline__ void xcd_barrier(const XcdBarrier& b) {
    asm volatile("s_waitcnt vmcnt(0)" ::: "memory");
    __syncthreads();
    if (threadIdx.x == 0) {
        unsigned* bar = b.bar;
        __builtin_amdgcn_s_waitcnt(0);
        unsigned nloc = b.st[0], nx = b.st[1];
        if (nloc == 0u) { xcd_barrier_complete(bar, b.x, nloc, nx); b.st[0] = nloc; b.st[1] = nx; }
        const unsigned old = xb_add(&bar[XB_XSUB(b.x)], 1u);
        const unsigned gen = old / nloc;
        if (old + 1u == (gen + 1u) * nloc) {
            __builtin_amdgcn_fence(__ATOMIC_RELEASE, "agent");
            asm volatile("s_waitcnt vmcnt(0)" ::: "memory");
            const unsigned og = xb_add(&bar[XB_TOP], 1u);
            const unsigned tg = og / nx;
            if (og + 1u == (tg + 1u) * nx) xb_add(&bar[XB_TOPGEN], 1u);
            else XB_SPIN(xb_ld(&bar[XB_TOPGEN]) == tg, bar);
            __builtin_amdgcn_fence(__ATOMIC_ACQUIRE, "agent");
            xb_add(&bar[XB_XGEN(b.x)], 1u);
            asm volatile("s_waitcnt vmcnt(0)" ::: "memory");
        } else {
            XB_SPIN(xb_ld(&bar[XB_XGEN(b.x)]) == gen, bar);
            __builtin_amdgcn_fence(__ATOMIC_ACQUIRE, "agent");
            asm volatile("s_waitcnt vmcnt(0)" ::: "memory");
        }
    }
    __syncthreads();
}

#ifndef DUP_SET
#define DUP_SET 0
#endif
__host__ __device__ constexpr bool dup_phase(int ph) {
    if (DUP_SET == 1) return ph == 2 || ph == 4 || ph == 6 || ph == 7 || ph == 9 || ph == 11 || ph == 14 || ph == 16 || ph == 17 || ph == 20 || ph == 22 || ph == 24 || ph == 25 || ph == 27 || ph == 29 || ph == 31 || ph == 32;
    if (DUP_SET == 2) return ph == 21;
    if (DUP_SET == 4) return ph == 4 || ph == 7 || ph == 14 || ph == 17 || ph == 22 || ph == 25 || ph == 29 || ph == 32;
    if (DUP_SET == 5) return ph == 0;
    if (DUP_SET == 6) return ph == 6 || ph == 16 || ph == 24 || ph == 31;
    if (DUP_SET == 3) return ph == 3 || ph == 28 || ph == 10 || ph == 12;
    return false;
}
template <int PH>
__device__ __forceinline__ void run_all(const Params& p, char* smem, const XcdBarrier& xb) {
    if constexpr (PH < NPHASES) {
        if constexpr (dup_phase(PH)) { run_phase(p, PH, smem); xcd_barrier(xb); }
#ifdef ONLY_LO
        if constexpr (PH >= ONLY_LO && PH <= ONLY_HI)
#endif
        run_phase(p, PH, smem);
        if constexpr (PH + 1 < NPHASES) {
            xcd_barrier(xb);
        }
        run_all<PH + 1>(p, smem, xb);
    }
}
constexpr int LDS_PHASE = 131072;
constexpr int DYN_LDS = LDS_PHASE + 16;
__global__ void __launch_bounds__(512, 2) mega(const Params p) {
    extern __shared__ __attribute__((aligned(16))) char smem[];
    volatile LAS unsigned* st = (volatile LAS unsigned*)(smem + LDS_PHASE);
    if (threadIdx.x < 4) st[threadIdx.x] = 0u;
    __syncthreads();
    const XcdBarrier xb = xcd_barrier_post((unsigned*)(p.ws + OFF_BAR), st);
    if (p.pad != 0) cg::this_grid().sync();
    run_all<0>(p, smem, xb);
}

static void add_job(Params& P, int& nj, int& tiles, const float* src, bf16_t* dst, const float* kscale, int K, int N, int ld, int mode, int rmul, int roff) {
    ConvJob& j = P.jobs[nj++];
    j.src = src; j.dst = dst; j.kscale = kscale; j.K = K; j.N = N; j.ld = ld; j.mode = mode; j.rmul = rmul; j.roff = roff; j.tile0 = tiles; j.pad = 0;
    tiles += (K / 128) * (N / 128);
}

extern "C" void kernel_launch(void* const* d_in, const int* in_sizes, int n_in, void* d_out, int out_size, void* d_ws, size_t ws_size, hipStream_t stream) {
    if (n_in != 27 || ws_size < WS_NEED || out_size != TL * DM) { (void)hipMemsetAsync(d_out, 0, (size_t)out_size * 4, stream); fprintf(stderr, "kernel_launch: unexpected sizes (n_in %d ws %zu need %zu out %d)\n", n_in, ws_size, (size_t)WS_NEED, out_size); return; }
    Params P;
    memset(&P, 0, sizeof(P));
    for (int i = 0; i < 27; ++i) P.in[i] = (const float*)d_in[i];
    P.out = (float*)d_out;
    P.ws = (char*)d_ws;
    bf16_t* WB = (bf16_t*)((char*)d_ws + OFF_WB);
    int nj = 0, tiles = 0;
    for (int l = 0; l < 4; ++l) {
        add_job(P, nj, tiles, P.in[7] + (size_t)l * 1024 * 5632, WB + wo_gu(l), nullptr, 1024, 5632, 5632, 1, 1, 0);
        add_job(P, nj, tiles, P.in[8] + (size_t)l * FH * 1024, WB + wo_dn(l), nullptr, FH, 1024, 1024, 0, 1, 0);
    }
    for (int j = 0; j < 2; ++j) {
        add_job(P, nj, tiles, P.in[9] + (size_t)j * 1024 * 1536, WB + wo_aqkv(j), nullptr, 1024, 1536, 1536, 5, 1, 0);
        add_job(P, nj, tiles, P.in[11] + (size_t)j * 1024 * 1024, WB + wo_ao(j), nullptr, 1024, 1024, 1024, 0, 1, 0);
    }
    add_job(P, nj, tiles, P.in[12], WB + WO_BIN, nullptr, 1024, 2048, 2048, 0, 1, 0);
    for (int dir = 0; dir < 2; ++dir)
        for (int blk = 0; blk < 4; ++blk) {
            add_job(P, nj, tiles, P.in[16] + (size_t)(dir * 4 + blk) * 65536, WB + WO_BG, nullptr, 256, 256, 256, 0, 2, dir * 2048 + blk * 512 + 0);
            add_job(P, nj, tiles, P.in[18] + (size_t)(dir * 4 + blk) * 65536, WB + WO_BG, nullptr, 256, 256, 256, 0, 2, dir * 2048 + blk * 512 + 1);
        }
    add_job(P, nj, tiles, P.in[20], WB + WO_BOUT, nullptr, 1024, 1024, 1024, 0, 1, 0);
    add_job(P, nj, tiles, P.in[21], WB + WO_CIN, nullptr, 1024, 1024, 832, 2, 1, 0);
    add_job(P, nj, tiles, P.in[24], WB + WO_CUQ, P.in[22], 512, 1536, 1536, 0, 1, 0);
    add_job(P, nj, tiles, P.in[25], WB + WO_CUKV, P.in[23], 256, 2048, 2048, 3, 1, 0);
    add_job(P, nj, tiles, P.in[26], WB + WO_COUT, nullptr, 1024, 1024, 1024, 0, 1, 0);
    P.conv_tiles = tiles;
    if (nj != NJOBS) { fprintf(stderr, "job count %d\n", nj); return; }

    static int grid_blocks = 0;
    if (!grid_blocks) {
        int dev = 0, cus = 0, per_cu = 0;
        (void)hipGetDevice(&dev);
        (void)hipDeviceGetAttribute(&cus, hipDeviceAttributeMultiprocessorCount, dev);
        (void)hipFuncSetAttribute((const void*)mega, hipFuncAttributeMaxDynamicSharedMemorySize, DYN_LDS);
        (void)hipOccupancyMaxActiveBlocksPerMultiprocessor(&per_cu, mega, 512, DYN_LDS);
        if (per_cu > 1) per_cu = 1;
        if (per_cu < 1) per_cu = 1;
        grid_blocks = cus * per_cu;
    }
    (void)hipMemsetAsync((char*)d_ws + OFF_BAR, 0, 16384, stream);
    void* args[] = {(void*)&P};
    hipError_t e = hipLaunchCooperativeKernel((void*)mega, dim3(grid_blocks), dim3(512), args, DYN_LDS, stream);
    if (e != hipSuccess) fprintf(stderr, "cooperative launch failed: %s (grid %d)\n", hipGetErrorString(e), grid_blocks);
}
```

```cpp
#include <hip/hip_runtime.h>
#include <hip/hip_cooperative_groups.h>
#include <cstdio>
#include <cstring>
namespace cg = cooperative_groups;


typedef unsigned short bf16_t;
typedef short bf16x8 __attribute__((ext_vector_type(8)));
typedef float f32x4 __attribute__((ext_vector_type(4)));
typedef unsigned u32x2 __attribute__((ext_vector_type(2)));
typedef unsigned u32x4 __attribute__((ext_vector_type(4)));

constexpr int NT = 16640, NCTX = 256, TL = 16384, DM = 1024, FH = 2816, NRB = 130;
constexpr float RMS_EPS = 1e-6f;
constexpr float LOG2E = 1.4426950408889634f;

constexpr size_t E_GU = 5632ull * 1024, E_DN = 1024ull * 2816;
constexpr size_t WO_GU0 = 0;
__host__ __device__ constexpr size_t wo_gu(int l) { return (size_t)l * (E_GU + E_DN); }
__host__ __device__ constexpr size_t wo_dn(int l) { return wo_gu(l) + E_GU; }
constexpr size_t WO_A0 = 4 * (E_GU + E_DN);
__host__ __device__ constexpr size_t wo_aqkv(int j) { return WO_A0 + (size_t)j * (1536ull * 1024 + 1024ull * 1024); }
__host__ __device__ constexpr size_t wo_ao(int j) { return wo_aqkv(j) + 1536ull * 1024; }
constexpr size_t WO_BIN = WO_A0 + 2 * (1536ull * 1024 + 1024ull * 1024);
constexpr size_t WO_BG = WO_BIN + 2048ull * 1024;
constexpr size_t WO_BOUT = WO_BG + 4096ull * 256;
constexpr size_t WO_CIN = WO_BOUT + 1024ull * 1024;
constexpr size_t WO_CUQ = WO_CIN + 1024ull * 1024;
constexpr size_t WO_CUKV = WO_CUQ + 1536ull * 512;
constexpr size_t WO_COUT = WO_CUKV + 2048ull * 256;
constexpr size_t WO_END = WO_COUT + 1024ull * 1024;

constexpr size_t OFF_WB = 0;
constexpr size_t OFF_MOD = OFF_WB + WO_END * 2;
constexpr size_t OFF_ROPEA = OFF_MOD + 4 * 2 * 6144 * 4;
constexpr size_t OFF_ROPEC = OFF_ROPEA + 2 * 256 * 32 * 4;
constexpr size_t OFF_GBIAS = OFF_ROPEC + 2 * 256 * 16 * 4;
constexpr size_t OFF_SS = OFF_GBIAS + 4096 * 4;
constexpr size_t OFF_SCAN = OFF_SS + (size_t)NT * 2 * 4;
constexpr size_t OFF_BAR = OFF_SCAN + 2ull * 2 * NRB * 1024 * 4;
constexpr size_t OFF_XC = OFF_BAR + 16384;
constexpr size_t OFF_H = OFF_XC + 256ull * 1024 * 4;
constexpr size_t OFF_Y = OFF_H + (size_t)NT * 1024 * 2;
constexpr size_t OFF_BIG = OFF_Y + (size_t)NT * 1024 * 4;
constexpr size_t SZ_ROW1K = (size_t)NT * 1024 * 2;
constexpr size_t WS_NEED = OFF_BIG + 4 * SZ_ROW1K;
constexpr size_t BA_Q = 0, BA_K = SZ_ROW1K, BA_VT = BA_K + (size_t)NT * 256 * 2;
constexpr size_t BB_GATES = 0;
constexpr size_t OFF_ZX = OFF_Y + SZ_ROW1K;
constexpr size_t OFF_ZQ = OFF_Y, OFF_ZKV = OFF_ZQ + (size_t)NT * 512 * 2, OFF_KR = OFF_ZKV + (size_t)NT * 256 * 2;
constexpr size_t BC_QC = 0, BC_KN = BC_QC + (size_t)NT * 1536 * 2, BC_VT = BC_KN + SZ_ROW1K;
static_assert(BC_VT + SZ_ROW1K <= 4 * SZ_ROW1K, "layer C overflow");
static_assert((size_t)NT * FH * 2 <= 4 * SZ_ROW1K, "ffn hid overflow");
static_assert(BA_VT + (size_t)NT * 256 * 2 <= 4 * SZ_ROW1K, "layer A overflow");

struct ConvJob { const float* src; bf16_t* dst; const float* kscale; int K, N, ld, mode, rmul, roff, tile0, pad; };
constexpr int NJOBS = 34;
struct Params {
    const float* in[27];
    float* out;
    char* ws;
    ConvJob jobs[NJOBS];
    int conv_tiles;
    int pad;
};

typedef float f32x2_t __attribute__((ext_vector_type(2)));
typedef __bf16 bf16x2_t __attribute__((ext_vector_type(2)));
__device__ __forceinline__ unsigned cvt_pk(float lo, float hi) { f32x2_t v = {lo, hi}; bf16x2_t b = __builtin_convertvector(v, bf16x2_t); return __builtin_bit_cast(unsigned, b); }
__device__ __forceinline__ float bf2f(unsigned h) { return __uint_as_float(h << 16); }
__device__ __forceinline__ float bflo(unsigned w) { return __uint_as_float(w << 16); }
__device__ __forceinline__ float bfhi(unsigned w) { return __uint_as_float(w & 0xffff0000u); }
__device__ __forceinline__ float fast_exp2(float x) { return __builtin_amdgcn_exp2f(x); }
__device__ __forceinline__ float sigmoidf_(float x) { return 1.0f / (1.0f + __expf(-x)); }
__device__ __forceinline__ float siluf_(float x) { return x * __builtin_amdgcn_rcpf(1.0f + __builtin_amdgcn_exp2f(-LOG2E * x)); }
__device__ __forceinline__ float gelu_tanh(float x) {
    const float u = 0.7978845608028654f * (x + 0.044715f * x * x * x);
    const float e = __expf(2.0f * u);
    const float t = 1.0f - 2.0f * __builtin_amdgcn_rcpf(e + 1.0f);
    return 0.5f * x * (1.0f + t);
}
__device__ __forceinline__ float wave_sum(float v) {
#pragma unroll
    for (int o = 32; o > 0; o >>= 1) v += __shfl_xor(v, o);
    return v;
}

__device__ __forceinline__ int tid_() { int t = threadIdx.x; asm volatile("" : "+v"(t)); return t; }


namespace pg8 {
#define PG8_LAS __attribute__((address_space(3)))
typedef unsigned short bf16_t;
typedef short bf16x8 __attribute__((ext_vector_type(8)));
typedef float f32x4 __attribute__((ext_vector_type(4)));
typedef unsigned u32x4 __attribute__((ext_vector_type(4)));
constexpr int BM = 256, BK = 64, HALF = 128, HTB = HALF * BK * 2  , STAGE_BYTES = 8 * HTB, NXCD = 8, WGM = 8;

__host__ __device__ __forceinline__ int lds_byte(int r, int c) { const int st = (r >> 4) * 2 + (c >> 5), rr = r & 15, cc = c & 31, ob = rr * 64 + cc * 2; return st * 1024 + (ob ^ (((ob >> 9) & 1) << 5)); }
__host__ __device__ __forceinline__ void stage_rc(int b, int& R, int& C) { const int st = b / 1024, sb = b % 1024, swz = sb ^ (((sb >> 9) & 1) << 5); R = (st >> 1) * 16 + swz / 64; C = (st & 1) * 32 + (swz % 64) / 2; }
__host__ __device__ __forceinline__ int perm32(int rho) { const int n = rho >> 4, i = rho & 15; return 8 * (i >> 2) + 4 * n + (i & 3); }

struct Unit { int pm, pn; };
struct Gemm { const bf16_t* A; const bf16_t* Bt; int M, N, K, lda, bdiag; };

struct StaticOrder {
    int nM, nN, nwg, G, c;
    __host__ __device__ void init(int M, int N, int G_, int c_) { nM = M / BM; nN = N / BM; nwg = nM * nN; G = G_; c = c_; }
    __host__ __device__ bool next(int i, Unit& u) const {
        const long L = (long)i * G + c; if (L >= nwg) return false;
        int wgid = (int)L; { const int q = nwg / NXCD, r = nwg % NXCD, xcd = wgid % NXCD, off = wgid / NXCD; wgid = (xcd < r ? xcd * (q + 1) : r * (q + 1) + (xcd - r) * q) + off; }
        const int nig = WGM * nN, gid = wgid / nig, fm = gid * WGM, gsz = (nM - fm) < WGM ? (nM - fm) : WGM;
        u.pm = fm + ((wgid % nig) % gsz); u.pn = (wgid % nig) / gsz; return true;
    }
    __device__ __forceinline__ void a_ready(const Unit&) const {}
    __device__ __forceinline__ void done(const Unit&) const {}
};
template <class Epi, class Sched, bool ALIGN_EPI = false, bool SP2 = false>
__device__ __forceinline__ void gemm_phase(PG8_LAS unsigned char* lds, const Gemm g, const Sched& S, const Epi& E) {
    const int tid = tid_(), wid = __builtin_amdgcn_readfirstlane(tid >> 6), lane = tid & 63, wr = wid >> 2, wc = wid & 3, fr = lane & 15, fq = lane >> 4;
    const int K = g.K, nt = K / BK;
    unsigned voffA[2], voffB[2];
#pragma unroll
    for (int i = 0; i < 2; ++i) { int R, C; stage_rc(tid * 16 + i * 8192, R, C); const int Rb = Epi::PERM ? ((R & ~31) + perm32(R & 31)) : R;
        voffA[i] = (unsigned)(R * g.lda + C) * 2u; voffB[i] = (unsigned)(Rb * K + C) * 2u; }
    const size_t kstep = (size_t)(BK * 2);
    const size_t hstep = (size_t)HALF * K * 2;
    const size_t tstep = 2 * hstep; const size_t hstepA = (size_t)HALF * g.lda * 2, tstepA = 2 * hstepA;
    const unsigned ldsw = (unsigned)wid * 1024u;
    const int aoff = lds_byte(wr * 64 + fr, fq * 8), boff = lds_byte(wc * 32 + fr, fq * 8);
#define PG8_SA(b, h) (((b) * 2 + (h)) * HTB)
#define PG8_SB(b, h) ((4 + (b) * 2 + (h)) * HTB)
#define PG8_STAGE(bufoff, gbase, voff) do { _Pragma("unroll") for (int _i = 0; _i < 2; ++_i) \
        __builtin_amdgcn_global_load_lds((const unsigned*)((const char*)(gbase) + (voff)[_i]), (PG8_LAS unsigned*)(lds + (bufoff) + ldsw + _i * 8192), 16, 0, 0); } while (0)
#define PG8_LDA(dst, b, h) do { _Pragma("unroll") for (int m = 0; m < 4; ++m) _Pragma("unroll") for (int k = 0; k < 2; ++k) dst[m][k] = *(const PG8_LAS bf16x8*)(lds + PG8_SA(b, h) + aoff + m * 2048 + k * 1024); } while (0)
#define PG8_LDB(dst, b, h) do { _Pragma("unroll") for (int n = 0; n < 2; ++n) _Pragma("unroll") for (int k = 0; k < 2; ++k) dst[n][k] = *(const PG8_LAS bf16x8*)(lds + PG8_SB(b, h) + boff + n * 2048 + k * 1024); } while (0)
#define PG8_MMA(ai, bj, At, Bt) do { __builtin_amdgcn_s_setprio(1); _Pragma("unroll") for (int m = 0; m < 4; ++m) _Pragma("unroll") for (int n = 0; n < 2; ++n) _Pragma("unroll") for (int k = 0; k < 2; ++k) \
        acc[ai][bj][m][n] = __builtin_amdgcn_mfma_f32_16x16x32_bf16(Bt[n][k], At[m][k], acc[ai][bj][m][n], 0, 0, 0); __builtin_amdgcn_s_setprio(0); } while (0)
#define PG8_WAIT_V(n) asm volatile("s_waitcnt vmcnt(" #n ")" ::: "memory")
#define PG8_WAIT_L(n) asm volatile("s_waitcnt lgkmcnt(" #n ")" ::: "memory")
#define PG8_BAR __builtin_amdgcn_s_barrier()
#define PG8_SCHED __builtin_amdgcn_sched_barrier(0)
    Unit cur, nxt; int ui = 0;
    if (!S.next(0, cur)) return;
    f32x4 acc[2][2][4][2];
#pragma unroll
    for (int a = 0; a < 2; ++a)
#pragma unroll
        for (int b = 0; b < 2; ++b)
#pragma unroll
            for (int m = 0; m < 4; ++m)
#pragma unroll
                for (int n = 0; n < 2; ++n) acc[a][b][m][n] = (f32x4){0.f, 0.f, 0.f, 0.f};
    bf16x8 At[4][2], B0[2][2], B1[2][2];
    const char* cA = (const char*)g.A + (size_t)cur.pm * tstepA + (g.bdiag ? ((cur.pn & 7) >> 1) * 512 : 0); const char* cB = (const char*)g.Bt + (size_t)cur.pn * tstep;
    S.a_ready(cur);
    if constexpr (SP2) {
        PG8_STAGE(PG8_SB(0, 0), cB, voffB); PG8_STAGE(PG8_SB(0, 1), cB + hstep, voffB); PG8_STAGE(PG8_SA(0, 0), cA, voffA); PG8_STAGE(PG8_SA(0, 1), cA + hstepA, voffA);
        if (wr == 1) PG8_BAR;
        PG8_WAIT_V(2); PG8_BAR;
        PG8_STAGE(PG8_SB(1, 0), cB + kstep, voffB); PG8_STAGE(PG8_SA(1, 0), cA + kstep, voffA); PG8_STAGE(PG8_SB(1, 1), cB + hstep + kstep, voffB);
        PG8_WAIT_V(6); PG8_BAR;
    } else {
        PG8_STAGE(PG8_SB(0, 0), cB, voffB); PG8_STAGE(PG8_SA(0, 0), cA, voffA); PG8_STAGE(PG8_SB(0, 1), cB + hstep, voffB); PG8_STAGE(PG8_SA(0, 1), cA + hstepA, voffA);
        if (wr == 1) PG8_BAR;
        PG8_WAIT_V(4); PG8_BAR;
        PG8_STAGE(PG8_SB(1, 0), cB + kstep, voffB); PG8_STAGE(PG8_SA(1, 0), cA + kstep, voffA); PG8_STAGE(PG8_SB(1, 1), cB + hstep + kstep, voffB);
        PG8_WAIT_V(6); PG8_BAR;
    }
    for (;;) {
        const bool has_next = S.next(ui + 1, nxt);
        const char* nA = has_next ? (const char*)g.A + (size_t)nxt.pm * tstepA + (g.bdiag ? ((nxt.pn & 7) >> 1) * 512 : 0) : cA; const char* nB = has_next ? (const char*)g.Bt + (size_t)nxt.pn * tstep : cB;
        for (int t = 0; t < nt; t += 2) {
            const bool last = (t == nt - 2);
            const char* a1 = cA + (size_t)(t + 1) * kstep;
            const char* a2 = last ? nA : cA + (size_t)(t + 2) * kstep; const char* b2 = last ? nB : cB + (size_t)(t + 2) * kstep;
            const char* a3 = a2 + kstep; const char* b3 = b2 + kstep;
            if (last && has_next) S.a_ready(nxt);
            if constexpr (SP2) {
            PG8_LDB(B0, 0, 0); PG8_LDB(B1, 0, 1); PG8_SCHED; PG8_LDA(At, 0, 0); PG8_STAGE(PG8_SA(1, 1), a1 + hstepA, voffA);
            PG8_WAIT_V(8); PG8_WAIT_L(0); PG8_BAR; PG8_MMA(0, 0, At, B0); PG8_MMA(0, 1, At, B1); PG8_BAR; PG8_SCHED;
            PG8_LDA(At, 0, 1); PG8_STAGE(PG8_SB(0, 0), b2, voffB); PG8_STAGE(PG8_SB(0, 1), b2 + hstep, voffB); PG8_STAGE(PG8_SA(0, 0), a2, voffA);
            PG8_WAIT_V(8); PG8_WAIT_L(0); PG8_BAR; PG8_MMA(1, 0, At, B0); PG8_MMA(1, 1, At, B1); PG8_BAR; PG8_SCHED;
            PG8_LDB(B0, 1, 0); PG8_LDB(B1, 1, 1); PG8_SCHED; PG8_LDA(At, 1, 0); PG8_STAGE(PG8_SA(0, 1), a2 + hstepA, voffA);
            PG8_WAIT_V(8); PG8_WAIT_L(0); PG8_BAR; PG8_MMA(0, 0, At, B0); PG8_MMA(0, 1, At, B1); PG8_BAR; PG8_SCHED;
            PG8_LDA(At, 1, 1); PG8_STAGE(PG8_SB(1, 0), b3, voffB); PG8_STAGE(PG8_SB(1, 1), b3 + hstep, voffB); PG8_STAGE(PG8_SA(1, 0), a3, voffA);
            PG8_WAIT_V(8); PG8_WAIT_L(0); PG8_BAR; PG8_MMA(1, 0, At, B0); PG8_MMA(1, 1, At, B1); PG8_BAR; PG8_SCHED;
            } else {
            PG8_LDB(B0, 0, 0); PG8_SCHED; PG8_LDA(At, 0, 0); PG8_STAGE(PG8_SA(1, 1), a1 + hstepA, voffA);
            PG8_WAIT_L(8); PG8_BAR; PG8_WAIT_L(0); PG8_MMA(0, 0, At, B0); PG8_BAR; PG8_SCHED;
            PG8_LDB(B1, 0, 1); PG8_STAGE(PG8_SB(0, 0), b2, voffB);
            PG8_BAR; PG8_WAIT_L(0); PG8_MMA(0, 1, At, B1); PG8_BAR;
            PG8_LDA(At, 0, 1); PG8_STAGE(PG8_SA(0, 0), a2, voffA);
            PG8_BAR; PG8_WAIT_L(0); PG8_MMA(1, 0, At, B0); PG8_BAR; PG8_SCHED;
            PG8_STAGE(PG8_SB(0, 1), b2 + hstep, voffB);
            PG8_WAIT_V(6); PG8_BAR; PG8_MMA(1, 1, At, B1); PG8_BAR;
            PG8_LDB(B0, 1, 0); PG8_SCHED; PG8_LDA(At, 1, 0); PG8_STAGE(PG8_SA(0, 1), a2 + hstepA, voffA);
            PG8_WAIT_L(8); PG8_BAR; PG8_WAIT_L(0); PG8_MMA(0, 0, At, B0); PG8_BAR; PG8_SCHED;
            PG8_LDB(B1, 1, 1); PG8_STAGE(PG8_SB(1, 0), b3, voffB);
            PG8_BAR; PG8_WAIT_L(0); PG8_MMA(0, 1, At, B1); PG8_BAR;
            PG8_LDA(At, 1, 1); PG8_STAGE(PG8_SA(1, 0), a3, voffA);
            PG8_BAR; PG8_WAIT_L(0); PG8_MMA(1, 0, At, B0); PG8_BAR; PG8_SCHED;
            PG8_STAGE(PG8_SB(1, 1), b3 + hstep, voffB);
            PG8_WAIT_V(6); PG8_BAR; PG8_MMA(1, 1, At, B1); PG8_BAR;
            }
        }
        if constexpr (ALIGN_EPI) { if (wr == 0) PG8_BAR; }
        if constexpr (!Epi::AFTER_DRAIN) { E(acc, cur, wr, wc, fr, fq); S.done(cur); }
        if (!has_next) break;
#pragma unroll
        for (int a = 0; a < 2; ++a)
#pragma unroll
            for (int b = 0; b < 2; ++b)
#pragma unroll
                for (int m = 0; m < 4; ++m)
#pragma unroll
                    for (int n = 0; n < 2; ++n) acc[a][b][m][n] = (f32x4){0.f, 0.f, 0.f, 0.f};
        cur = nxt; cA = nA; cB = nB; ++ui;
        if constexpr (ALIGN_EPI) { if (wr == 1) PG8_BAR; }
    }
    PG8_WAIT_V(0);
    if constexpr (!ALIGN_EPI) { if (wr == 0) PG8_BAR; }
    PG8_BAR;
    if constexpr (Epi::AFTER_DRAIN) { E.fused(acc, cur, wr, wc, fr, fq, lds, wid, lane); S.done(cur); }
#undef PG8_SA
#undef PG8_SB
#undef PG8_STAGE
#undef PG8_LDA
#undef PG8_LDB
#undef PG8_MMA
#undef PG8_WAIT_V
#undef PG8_WAIT_L
#undef PG8_BAR
#undef PG8_SCHED
}
}
using pg8::Unit;
#define EROW(ai, m) (u.pm * 256 + (ai) * 128 + wr * 64 + (m) * 16 + fr)
#define ECOL(bj, n) (u.pn * 256 + (bj) * 128 + wc * 32 + (n) * 16 + fq * 4)
typedef f32x4 acc_t[2][2][4][2];
__device__ __forceinline__ u32x2 pack4(const f32x4 v) { u32x2 w; w.x = cvt_pk(v[0], v[1]); w.y = cvt_pk(v[2], v[3]); return w; }

__device__ __forceinline__ int vt_pos(int t4) { return (t4 & ~31) + ((t4 & 12) << 1) + ((t4 & 16) >> 2); }
struct EpiF32 {
    static constexpr bool PERM = false, AFTER_DRAIN = false;
    bf16_t* Y; int ldc;
    __device__ __forceinline__ void operator()(const acc_t& acc, const Unit& u, int wr, int wc, int fr, int fq) const {
#pragma unroll
        for (int ai = 0; ai < 2; ++ai)
#pragma unroll
            for (int m = 0; m < 4; ++m)
#pragma unroll
                for (int bj = 0; bj < 2; ++bj)
#pragma unroll
                    for (int n = 0; n < 2; ++n) *(u32x2*)(Y + (size_t)EROW(ai, m) * ldc + ECOL(bj, n)) = pack4(acc[ai][bj][m][n]);
    }
};
struct EpiQK {
    static constexpr bool PERM = false, AFTER_DRAIN = false;
    bf16_t* Q; bf16_t* Kb; bf16_t* VT; const float* cosT; const float* sinT; float qscale;
    __device__ __forceinline__ void operator()(const acc_t& acc, const Unit& u, int wr, int wc, int fr, int fq) const {
        if (u.pn == 5) {
            const int b = fr & 3;
#pragma unroll
            for (int ai = 0; ai < 2; ++ai)
#pragma unroll
                for (int m = 0; m < 4; ++m)
#pragma unroll
                    for (int bj = 0; bj < 2; ++bj)
#pragma unroll
                        for (int n = 0; n < 2; ++n) {
                            f32x4 v = acc[ai][bj][m][n];
                            { const float t0 = (b & 1) ? v[0] : v[1], t1 = (b & 1) ? v[2] : v[3];
                              const float r0 = __shfl_xor(t0, 1), r1 = __shfl_xor(t1, 1);
                              if (b & 1) { v[0] = r0; v[2] = r1; } else { v[1] = r0; v[3] = r1; } }
                            { const float t0 = (b & 2) ? v[0] : v[2], t1 = (b & 2) ? v[1] : v[3];
                              const float r0 = __shfl_xor(t0, 2), r1 = __shfl_xor(t1, 2);
                              if (b & 2) { v[0] = r0; v[1] = r1; } else { v[2] = r0; v[3] = r1; } }
                            const int col = ECOL(bj, n) - 1280 + b, row = EROW(ai, m) - b;
                            *(u32x2*)(VT + (size_t)col * NT + vt_pos(row)) = pack4(v);
                        }
            return;
        }
        const bool isq = u.pn < 4;
        const float sc = isq ? qscale : 1.0f;
        const int axis = wc >> 1, fh = wc & 1;
#pragma unroll
        for (int ai = 0; ai < 2; ++ai)
#pragma unroll
            for (int m = 0; m < 4; ++m) {
                const int row = EROW(ai, m);
                f32x4 c = (f32x4){1.f, 1.f, 1.f, 1.f}, s = (f32x4){0.f, 0.f, 0.f, 0.f};
                if (row >= NCTX) {
                    const int t = row - NCTX, pos = axis ? (t & 63) : (t >> 6);
                    c = *(const f32x4*)(cosT + pos * 32 + fh * 16 + fq * 4);
                    s = *(const f32x4*)(sinT + pos * 32 + fh * 16 + fq * 4);
                }
#pragma unroll
                for (int bj = 0; bj < 2; ++bj) {
                    const f32x4 x1 = acc[ai][bj][m][0], x2 = acc[ai][bj][m][1];
                    const f32x4 o1 = (x1 * c - x2 * s) * sc, o2 = (x2 * c + x1 * s) * sc;
                    if (isq) { *(u32x2*)(Q + (size_t)row * 1024 + ECOL(bj, 0)) = pack4(o1); *(u32x2*)(Q + (size_t)row * 1024 + ECOL(bj, 1)) = pack4(o2); }
                    else { *(u32x2*)(Kb + (size_t)row * 256 + ECOL(bj, 0) - 1024) = pack4(o1); *(u32x2*)(Kb + (size_t)row * 256 + ECOL(bj, 1) - 1024) = pack4(o2); }
                }
            }
    }
};
struct EpiVT {
    static constexpr bool PERM = false, AFTER_DRAIN = false;
    bf16_t* VT; const float* ss; int ssidx; float inv_dim;
    __device__ __forceinline__ void operator()(const acc_t& acc, const Unit& u, int wr, int wc, int fr, int fq) const {
#pragma unroll
        for (int bj = 0; bj < 2; ++bj)
#pragma unroll
            for (int n = 0; n < 2; ++n) {
                const int col = ECOL(bj, n);
                f32x4 rs = (f32x4){1.f, 1.f, 1.f, 1.f};
                if (ss) {
#pragma unroll
                    for (int i = 0; i < 4; ++i) rs[i] = rsqrtf(ss[(col + i) * 2 + ssidx] * inv_dim + RMS_EPS);
                }
#pragma unroll
                for (int ai = 0; ai < 2; ++ai)
#pragma unroll
                    for (int m = 0; m < 4; ++m) *(u32x2*)(VT + (size_t)EROW(ai, m) * NT + vt_pos(col)) = pack4(acc[ai][bj][m][n] * rs);
            }
    }
};
struct EpiBin {
    static constexpr bool PERM = false, AFTER_DRAIN = false;
    bf16_t* ZX; bf16_t* G;
    __device__ __forceinline__ void operator()(const acc_t& acc, const Unit& u, int wr, int wc, int fr, int fq) const {
        const bool isg = u.pn >= 4;
        bf16_t* dst = isg ? G : ZX;
#pragma unroll
        for (int ai = 0; ai < 2; ++ai)
#pragma unroll
            for (int m = 0; m < 4; ++m)
#pragma unroll
                for (int bj = 0; bj < 2; ++bj)
#pragma unroll
                    for (int n = 0; n < 2; ++n) {
                        f32x4 v = acc[ai][bj][m][n];
                        if (isg) { v[0] = gelu_tanh(v[0]); v[1] = gelu_tanh(v[1]); v[2] = gelu_tanh(v[2]); v[3] = gelu_tanh(v[3]); }
                        *(u32x2*)(dst + (size_t)EROW(ai, m) * 1024 + (ECOL(bj, n) & 1023)) = pack4(v);
                    }
    }
};
struct EpiGates {
    static constexpr bool PERM = false, AFTER_DRAIN = false;
    bf16_t* O; const float* bias;
    __device__ __forceinline__ void operator()(const acc_t& acc, const Unit& u, int wr, int wc, int fr, int fq) const {
#pragma unroll
        for (int ai = 0; ai < 2; ++ai)
#pragma unroll
            for (int m = 0; m < 4; ++m) {
                bf16_t* orow = O + (size_t)EROW(ai, m) * 4096;
#pragma unroll
                for (int bj = 0; bj < 2; ++bj)
#pragma unroll
                    for (int n = 0; n < 2; ++n) {
                        const int col = ECOL(bj, n);
                        const f32x4 v = (acc[ai][bj][m][n] + *(const f32x4*)(bias + col)) * (-LOG2E);
                        f32x4 sg;
#pragma unroll
                        for (int i = 0; i < 4; ++i) sg[i] = __builtin_amdgcn_rcpf(1.0f + fast_exp2(v[i]));
                        *(u32x2*)(orow + col) = pack4(sg);
                    }
                asm volatile("" ::: "memory");
            }
    }
};
struct EpiCin {
    static constexpr bool PERM = false, AFTER_DRAIN = false;
    bf16_t* ZQ; bf16_t* ZKV; bf16_t* KR; float* ss; const float* cosT; const float* sinT;
    __device__ __forceinline__ void operator()(const acc_t& acc, const Unit& u, int wr, int wc, int fr, int fq) const {
        if (u.pn < 3) {
            const int which = u.pn < 2 ? 0 : 1;
#pragma unroll
            for (int ai = 0; ai < 2; ++ai)
#pragma unroll
                for (int m = 0; m < 4; ++m) {
                    const int row = EROW(ai, m);
                    float s = 0.f;
#pragma unroll
                    for (int bj = 0; bj < 2; ++bj)
#pragma unroll
                        for (int n = 0; n < 2; ++n) {
                            const f32x4 v = acc[ai][bj][m][n];
                            s += v[0] * v[0] + v[1] * v[1] + v[2] * v[2] + v[3] * v[3];
                            if (which == 0) *(u32x2*)(ZQ + (size_t)row * 512 + ECOL(bj, n)) = pack4(v);
                            else *(u32x2*)(ZKV + (size_t)row * 256 + ECOL(bj, n) - 512) = pack4(v);
                        }
                    s += __shfl_xor(s, 16); s += __shfl_xor(s, 32);
                    if (fq == 0) atomicAdd(ss + row * 2 + which, s);
                }
        } else if (wc < 2) {
#pragma unroll
            for (int ai = 0; ai < 2; ++ai)
#pragma unroll
                for (int m = 0; m < 4; ++m) {
                    const int row = EROW(ai, m);
                    f32x4 x1 = acc[ai][0][m][0], x2 = acc[ai][0][m][1];
                    if (row >= NCTX) {
                        const int t = row - NCTX, pos = wc ? (t & 63) : (t >> 6);
                        const f32x4 c = *(const f32x4*)(cosT + pos * 16 + 4 * fq);
                        const f32x4 s = *(const f32x4*)(sinT + pos * 16 + 4 * fq);
                        const f32x4 o1 = x1 * c - x2 * s, o2 = x2 * c + x1 * s;
                        x1 = o1; x2 = o2;
                    }
                    *(u32x2*)(KR + (size_t)row * 64 + wc * 32 + fq * 4) = pack4(x1);
                    *(u32x2*)(KR + (size_t)row * 64 + wc * 32 + 16 + fq * 4) = pack4(x2);
                }
        }
    }
};
struct EpiQc {
    static constexpr bool PERM = false, AFTER_DRAIN = false;
    bf16_t* QC; const float* ss; const float* cosT; const float* sinT; float qscale;
    __device__ __forceinline__ void operator()(const acc_t& acc, const Unit& u, int wr, int wc, int fr, int fq) const {
#pragma unroll
        for (int ai = 0; ai < 2; ++ai)
#pragma unroll
            for (int m = 0; m < 4; ++m) {
                const int row = EROW(ai, m);
                const float rs = rsqrtf(ss[row * 2] * (1.0f / 512.0f) + RMS_EPS) * qscale;
#pragma unroll
                for (int bj = 0; bj < 2; ++bj) {
                    const int cb = u.pn * 256 + bj * 128 + wc * 32;
                    const int grp = (cb % 192) >> 5;
                    f32x4 x1 = acc[ai][bj][m][0], x2 = acc[ai][bj][m][1];
                    if (grp >= 4 && row >= NCTX) {
                        const int t = row - NCTX, pos = (grp == 5) ? (t & 63) : (t >> 6);
                        const f32x4 c = *(const f32x4*)(cosT + pos * 16 + 4 * fq);
                        const f32x4 s = *(const f32x4*)(sinT + pos * 16 + 4 * fq);
                        const f32x4 o1 = x1 * c - x2 * s, o2 = x2 * c + x1 * s;
                        x1 = o1; x2 = o2;
                    }
                    *(u32x2*)(QC + (size_t)row * 1536 + cb + fq * 4) = pack4(x1 * rs);
                    *(u32x2*)(QC + (size_t)row * 1536 + cb + 16 + fq * 4) = pack4(x2 * rs);
                }
            }
    }
};
struct EpiKn {
    static constexpr bool PERM = false, AFTER_DRAIN = false;
    bf16_t* KN; const float* ss;
    __device__ __forceinline__ void operator()(const acc_t& acc, const Unit& u, int wr, int wc, int fr, int fq) const {
#pragma unroll
        for (int ai = 0; ai < 2; ++ai)
#pragma unroll
            for (int m = 0; m < 4; ++m) {
                const int row = EROW(ai, m);
                const float rs = rsqrtf(ss[row * 2 + 1] * (1.0f / 256.0f) + RMS_EPS);
#pragma unroll
                for (int bj = 0; bj < 2; ++bj)
#pragma unroll
                    for (int n = 0; n < 2; ++n) *(u32x2*)(KN + (size_t)row * 1024 + ECOL(bj, n)) = pack4(acc[ai][bj][m][n] * rs);
            }
    }
};
struct EpiGU {
    static constexpr bool PERM = false, AFTER_DRAIN = false;
    bf16_t* HID;
    __device__ __forceinline__ void operator()(const acc_t& acc, const Unit& u, int wr, int wc, int fr, int fq) const {
#pragma unroll
        for (int ai = 0; ai < 2; ++ai)
#pragma unroll
            for (int m = 0; m < 4; ++m) {
                const int row = EROW(ai, m);
#pragma unroll
                for (int bj = 0; bj < 2; ++bj) {
                    const int u0 = ((u.pn * 256 + bj * 128 + wc * 32) >> 5) * 16;
                    const f32x4 a = acc[ai][bj][m][0], b = acc[ai][bj][m][1];
                    const f32x4 h = (f32x4){siluf_(a[0]) * b[0], siluf_(a[1]) * b[1], siluf_(a[2]) * b[2], siluf_(a[3]) * b[3]};
                    *(u32x2*)(HID + (size_t)row * FH + u0 + fq * 4) = pack4(h);
                }
            }
    }
};
template <class Epi, bool ALIGN = true>
__device__ __forceinline__ void gemm(char* smem, const bf16_t* A, int lda, const bf16_t* Bt, int M, int N, int K, int bdiag, int rot, const Epi& e) {
    pg8::Gemm g{A, Bt, M, N, K, lda, bdiag};
    pg8::StaticOrder S; S.init(M, N, (int)gridDim.x, (int)((blockIdx.x + rot) % gridDim.x));
    pg8::gemm_phase<Epi, pg8::StaticOrder, ALIGN, true>((PG8_LAS unsigned char*)smem, g, S, e);
}

__device__ __forceinline__ void ctx_gemm_f32(char* smem, const bf16_t* __restrict__ A, int lda, const bf16_t* __restrict__ Bt, int K, bf16_t* __restrict__ Y) {
    const int tid = tid_(), lane = tid & 63, wid = tid >> 6, l16 = lane & 15, g = lane >> 4;
    f32x4* red = (f32x4*)smem;
    for (int t = blockIdx.x; t < 256; t += gridDim.x) {
        const int r0 = (t >> 4) * 16, c0 = (t & 15) * 64;
        const int kper = K >> 3, kbeg = wid * kper;
        const bf16_t* ap = A + (size_t)(r0 + l16) * lda + kbeg + g * 8;
        const bf16_t* bp = Bt + (size_t)(c0 + l16) * K + kbeg + g * 8;
        f32x4 acc[4];
#pragma unroll
        for (int n = 0; n < 4; ++n) acc[n] = (f32x4){0.f, 0.f, 0.f, 0.f};
#pragma unroll 4
        for (int k = 0; k < kper; k += 32) {
            const bf16x8 af = *(const bf16x8*)(ap + k);
#pragma unroll
            for (int n = 0; n < 4; ++n) {
                const bf16x8 bf = *(const bf16x8*)(bp + (size_t)n * 16 * K + k);
                acc[n] = __builtin_amdgcn_mfma_f32_16x16x32_bf16(bf, af, acc[n], 0, 0, 0);
            }
        }
        __syncthreads();
#pragma unroll
        for (int n = 0; n < 4; ++n) red[(wid * 4 + n) * 64 + lane] = acc[n];
        __syncthreads();
        if (tid < 256) {
            const int n = tid >> 6, ln = tid & 63;
            f32x4 sum = red[n * 64 + ln];
#pragma unroll
            for (int w = 1; w < 8; ++w) sum += red[(w * 4 + n) * 64 + ln];
            *(u32x2*)(Y + (size_t)(r0 + (ln & 15)) * 1024 + c0 + 16 * n + 4 * (ln >> 4)) = pack4(sum);
        }
    }
    __syncthreads();
}

__device__ __forceinline__ float xmax16_32(float x) {
    const unsigned xb = __float_as_uint(x);
    const auto r16 = __builtin_amdgcn_permlane16_swap(xb, xb, false, false);
    const float a = fmaxf(__uint_as_float(r16[0]), __uint_as_float(r16[1]));
    const unsigned ab = __float_as_uint(a);
    const auto r32 = __builtin_amdgcn_permlane32_swap(ab, ab, false, false);
    return fmaxf(__uint_as_float(r32[0]), __uint_as_float(r32[1]));
}
#ifndef ATT_SKEW
#define ATT_SKEW 10
#endif
template <int DQK, bool WINDOW>
__device__ __forceinline__ void attn_run(const bf16_t* __restrict__ Q, int ldq, const bf16_t* __restrict__ Kn, int ldk, int hdiv,
                                         const bf16_t* __restrict__ KR, const bf16_t* __restrict__ VT, bf16_t* __restrict__ O,
                                         const float* __restrict__ sinks, char* smem) {
    constexpr int KSTR = DQK * 2 + 16, VSTR = 144, NKC = DQK / 64, NKK = DQK / 32, KBUF = 64 * KSTR, VBUF = 128 * VSTR;
    char* Ks0 = smem;
    char* Vs0 = smem + 2 * KBUF;
    const int tid = tid_(), lane = tid & 63, wid = tid >> 6, l16 = lane & 15, g = lane >> 4;
    for (int u = blockIdx.x; u < 520; u += gridDim.x) {
        const bool ctxq = u >= 512;
        const int h = WINDOW ? (u & 1) * 4 + (wid >> 1) : (ctxq ? u - 512 : (u & 7));
        const int row0 = WINDOW ? (ctxq ? 64 * ((u - 512) >> 1) : NCTX + 64 * (u >> 1)) : (ctxq ? 0 : NCTX + 256 * (u >> 3));
        const int wrow = WINDOW ? 32 * (wid & 1) : 32 * wid;
        const int hk = WINDOW ? (u & 1) : h / hdiv;
        int lo = NCTX, hi = NT;
        if (WINDOW) { const int p0 = row0 - NCTX; lo = NCTX + (p0 - 128 > 0 ? p0 - 128 : 0); hi = NCTX + (p0 + 192 < TL ? p0 + 192 : TL); }
        const int nt = ctxq ? 4 : 4 + ((hi - lo) >> 6);
        bf16x8 qf[2][NKK];
#pragma unroll
        for (int q = 0; q < 2; ++q)
#pragma unroll
            for (int kk = 0; kk < NKK; ++kk)
                qf[q][kk] = *(const bf16x8*)(Q + (size_t)(row0 + wrow + 16 * q + l16) * ldq + h * DQK + kk * 32 + g * 8);
        f32x4 oacc[8][2];
#pragma unroll
        for (int d = 0; d < 8; ++d) { oacc[d][0] = (f32x4){0.f, 0.f, 0.f, 0.f}; oacc[d][1] = (f32x4){0.f, 0.f, 0.f, 0.f}; }
        float mrun[2], lrun[2];
        if (sinks) { const float s = sinks[h] * LOG2E; mrun[0] = mrun[1] = s; lrun[0] = lrun[1] = (g == 0) ? 1.f : 0.f; }
        else { mrun[0] = mrun[1] = -INFINITY; lrun[0] = lrun[1] = 0.f; }
        u32x4 rk[NKC], rv[2];
        const bf16_t* KnH = Kn + hk * 128;
        const bf16_t* VTH = VT + (size_t)hk * 128 * NT;
        auto prefetch_k = [&](int j) __attribute__((always_inline)) {
            const int t_ = tid_(), kr_ = t_ >> 3, kc_ = t_ & 7;
            const int k0 = j < 4 ? j * 64 : lo + (j - 4) * 64;
            const bf16_t* kb_ = KnH + (size_t)k0 * ldk + kr_ * ldk + kc_ * 8;
#pragma unroll
            for (int i = 0; i < 2; ++i) rk[i] = *(const u32x4*)(kb_ + i * 64);
            if (DQK > 128) rk[NKC - 1] = *(const u32x4*)(KR + (size_t)k0 * 64 + kr_ * 64 + kc_ * 8);
        };
        auto prefetch_v = [&](int j) __attribute__((always_inline)) {
            const int t_ = tid_(), vr_ = t_ >> 2, vc_ = (t_ & 3) * 2;
            const int k0 = j < 4 ? j * 64 : lo + (j - 4) * 64;
            const bf16_t* vb_ = VTH + k0 + vr_ * NT + vc_ * 8;
#pragma unroll
            for (int i = 0; i < 2; ++i) rv[i] = *(const u32x4*)(vb_ + i * 8);
        };
        auto write_kv = [&](int j) __attribute__((always_inline)) {
            const int t_ = tid_(), kr_ = t_ >> 3, kc_ = t_ & 7, vr_ = t_ >> 2, vc_ = (t_ & 3) * 2;
            char* kd = Ks0 + (j & 1) * KBUF + kr_ * KSTR + kc_ * 16;
            char* vd = Vs0 + (j & 1) * VBUF + vr_ * VSTR + vc_ * 16;
#pragma unroll
            for (int i = 0; i < NKC; ++i) *(u32x4*)(kd + i * 128) = rk[i];
#pragma unroll
            for (int i = 0; i < 2; ++i) *(u32x4*)(vd + i * 16) = rv[i];
        };
        __syncthreads();
        prefetch_k(0); prefetch_v(0); write_kv(0);
        prefetch_k(1); prefetch_v(1);
        for (int j = 0; j < nt; ++j) {
            __syncthreads();
            if (j + 1 < nt) write_kv(j + 1);
            if (j + 2 < nt) prefetch_k(j + 2);
            const char* Ks = Ks0 + (j & 1) * KBUF;
            const char* Vs = Vs0 + (j & 1) * VBUF;
            const int k0 = j < 4 ? j * 64 : lo + (j - 4) * 64;
            if (WINDOW && j >= 4) {
                const int q0 = row0 + wrow;
#if 1
                if (k0 > q0 + 31 + 128 || k0 + 63 < q0 - 128) { if (j + 2 < nt) prefetch_v(j + 2); continue; }
#endif
            }
            f32x4 sacc[4][2];
#pragma unroll
            for (int kb = 0; kb < 4; ++kb) { sacc[kb][0] = (f32x4){0.f, 0.f, 0.f, 0.f}; sacc[kb][1] = (f32x4){0.f, 0.f, 0.f, 0.f}; }
#pragma unroll
            for (int kk = 0; kk < NKK; ++kk) {
#pragma unroll
                for (int kb = 0; kb < 4; ++kb) {
                    const bf16x8 kf = *(const bf16x8*)(Ks + (16 * kb + l16) * KSTR + kk * 64 + g * 16);
                    sacc[kb][0] = __builtin_amdgcn_mfma_f32_16x16x32_bf16(kf, qf[0][kk], sacc[kb][0], 0, 0, 0);
                    sacc[kb][1] = __builtin_amdgcn_mfma_f32_16x16x32_bf16(kf, qf[1][kk], sacc[kb][1], 0, 0, 0);
                }
            }
            if (WINDOW && j >= 4) {
#pragma unroll
                for (int q = 0; q < 2; ++q) {
                    const int qp = row0 + wrow + 16 * q + l16;
#pragma unroll
                    for (int kb = 0; kb < 4; ++kb)
#pragma unroll
                        for (int i = 0; i < 4; ++i) {
                            const int d = k0 + 16 * kb + 4 * g + i - qp;
                            if (d > 128 || d < -128) sacc[kb][q][i] = -INFINITY;
                        }
                }
            }
            auto ldv = [&](int kg, int d) __attribute__((always_inline)) {
                return *(const bf16x8*)(Vs + (16 * d + l16) * VSTR + kg * 64 + g * 16);
            };
            if (j + 2 < nt) prefetch_v(j + 2);
            bf16x8 vfa[4], vfb[4];
#pragma unroll
            for (int d = 0; d < 4; ++d) vfa[d] = ldv(0, d);
            bf16x8 pf[2][2];
#pragma unroll
            for (int q = 0; q < 2; ++q) {
                float mx = -INFINITY;
#pragma unroll
                for (int kb = 0; kb < 4; ++kb) mx = fmaxf(mx, fmaxf(fmaxf(sacc[kb][q][0], sacc[kb][q][1]), fmaxf(sacc[kb][q][2], sacc[kb][q][3])));
                mx = xmax16_32(mx);
                const float mnew = fmaxf(mrun[q], mx);
                const float alpha = fast_exp2(mrun[q] - mnew);
                mrun[q] = mnew;
                float ps = 0.f;
                unsigned pw[8];
#pragma unroll
                for (int kb = 0; kb < 4; ++kb) {
                    const float p0 = fast_exp2(sacc[kb][q][0] - mnew), p1 = fast_exp2(sacc[kb][q][1] - mnew), p2 = fast_exp2(sacc[kb][q][2] - mnew), p3 = fast_exp2(sacc[kb][q][3] - mnew);
                    ps += (p0 + p1) + (p2 + p3);
                    pw[kb * 2] = cvt_pk(p0, p1); pw[kb * 2 + 1] = cvt_pk(p2, p3);
                }
                lrun[q] = lrun[q] * alpha + ps;
                u32x4 t0 = (u32x4){pw[0], pw[1], pw[2], pw[3]}, t1 = (u32x4){pw[4], pw[5], pw[6], pw[7]};
                pf[q][0] = __builtin_bit_cast(bf16x8, t0); pf[q][1] = __builtin_bit_cast(bf16x8, t1);
                if (__builtin_amdgcn_ballot_w64(alpha != 1.0f) != 0ull) {
#pragma unroll
                    for (int d = 0; d < 8; ++d) oacc[d][q] *= alpha;
                }
            }
#pragma unroll
            for (int d = 0; d < 4; ++d) {
                oacc[d][0] = __builtin_amdgcn_mfma_f32_16x16x32_bf16(vfa[d], pf[0][0], oacc[d][0], 0, 0, 0);
                oacc[d][1] = __builtin_amdgcn_mfma_f32_16x16x32_bf16(vfa[d], pf[1][0], oacc[d][1], 0, 0, 0);
                vfb[d] = ldv(0, d + 4);
            }
#pragma unroll
            for (int d = 0; d < 4; ++d) {
                oacc[d + 4][0] = __builtin_amdgcn_mfma_f32_16x16x32_bf16(vfb[d], pf[0][0], oacc[d + 4][0], 0, 0, 0);
                oacc[d + 4][1] = __builtin_amdgcn_mfma_f32_16x16x32_bf16(vfb[d], pf[1][0], oacc[d + 4][1], 0, 0, 0);
                vfa[d] = ldv(1, d);
            }
#pragma unroll
            for (int d = 0; d < 4; ++d) {
                oacc[d][0] = __builtin_amdgcn_mfma_f32_16x16x32_bf16(vfa[d], pf[0][1], oacc[d][0], 0, 0, 0);
                oacc[d][1] = __builtin_amdgcn_mfma_f32_16x16x32_bf16(vfa[d], pf[1][1], oacc[d][1], 0, 0, 0);
                vfb[d] = ldv(1, d + 4);
            }
#pragma unroll
            for (int d = 0; d < 4; ++d) {
                oacc[d + 4][0] = __builtin_amdgcn_mfma_f32_16x16x32_bf16(vfb[d], pf[0][1], oacc[d + 4][0], 0, 0, 0);
                oacc[d + 4][1] = __builtin_amdgcn_mfma_f32_16x16x32_bf16(vfb[d], pf[1][1], oacc[d + 4][1], 0, 0, 0);
            }
        }
#pragma unroll
        for (int q = 0; q < 2; ++q) {
            float l = lrun[q];
            l += __shfl_xor(l, 16); l += __shfl_xor(l, 32);
            const float inv = 1.0f / l;
            const int row = row0 + wrow + 16 * q + l16;
#pragma unroll
            for (int d = 0; d < 8; ++d) *(u32x2*)(O + (size_t)row * 1024 + h * 128 + 16 * d + 4 * g) = pack4(oacc[d][q] * inv);
        }
    }
    __syncthreads();
}

__device__ __forceinline__ void rownorm_phase(const Params& p, int mode, const float* gpost, int gate_idx, int mod_layer_post,
                                              const float* gpre, int shift_idx, int scale_idx, int mod_layer_pre, bool x_in = false) {
    const int tid0 = tid_(); const int lane = tid0 & 63, wv = tid0 >> 6;
    const int gw = blockIdx.x * 8 + wv, nw = gridDim.x * 8;
    float* XC = (float*)(p.ws + OFF_XC);
    const bf16_t* Y = (const bf16_t*)(p.ws + OFF_Y);
    bf16_t* H = (bf16_t*)(p.ws + OFF_H);
    const float* MOD = (const float*)(p.ws + OFF_MOD);
    for (int row = gw; row < NT; row += nw) {
        const int isctx = row < NCTX ? 1 : 0;
        float* xr = isctx ? XC + (size_t)row * 1024 : p.out + (size_t)(row - NCTX) * 1024;
        f32x4 x[4];
        const float* xsrc = isctx ? p.in[2] + (size_t)row * 1024 : p.in[0] + (size_t)(row - NCTX) * 1024;
        if (mode == 0) {
#pragma unroll
            for (int j = 0; j < 4; ++j) x[j] = *(const f32x4*)(xsrc + j * 256 + lane * 4);
        } else {
            f32x4 y[4];
            float ss = 0.f;
#pragma unroll
            for (int j = 0; j < 4; ++j) {
                { const u32x2 yw = *(const u32x2*)(Y + (size_t)row * 1024 + j * 256 + lane * 4); y[j] = (f32x4){bflo(yw.x), bfhi(yw.x), bflo(yw.y), bfhi(yw.y)}; }
                x[j] = *(const f32x4*)((x_in ? xsrc : xr) + j * 256 + lane * 4);
                ss += y[j][0] * y[j][0] + y[j][1] * y[j][1] + y[j][2] * y[j][2] + y[j][3] * y[j][3];
            }
            ss = wave_sum(ss);
            const float rinv = rsqrtf(ss * (1.0f / 1024.0f) + RMS_EPS);
            const float* gate = MOD + ((size_t)(mod_layer_post * 2 + isctx) * 6 + gate_idx) * 1024;
#pragma unroll
            for (int j = 0; j < 4; ++j) {
                const f32x4 gp = *(const f32x4*)(gpost + j * 256 + lane * 4);
                const f32x4 gt = *(const f32x4*)(gate + j * 256 + lane * 4);
                x[j] = x[j] + gt * (y[j] * rinv * gp);
            }
        }
        if (mode != 0) {
#pragma unroll
            for (int j = 0; j < 4; ++j) *(f32x4*)(xr + j * 256 + lane * 4) = x[j];
        }
        if (gpre) {
            float ss = 0.f;
#pragma unroll
            for (int j = 0; j < 4; ++j) ss += x[j][0] * x[j][0] + x[j][1] * x[j][1] + x[j][2] * x[j][2] + x[j][3] * x[j][3];
            ss = wave_sum(ss);
            const float rinv = rsqrtf(ss * (1.0f / 1024.0f) + RMS_EPS);
            const float* shift = MOD + ((size_t)(mod_layer_pre * 2 + isctx) * 6 + shift_idx) * 1024;
            const float* scale = MOD + ((size_t)(mod_layer_pre * 2 + isctx) * 6 + scale_idx) * 1024;
#pragma unroll
            for (int j = 0; j < 4; ++j) {
                const f32x4 gp = *(const f32x4*)(gpre + j * 256 + lane * 4);
                const f32x4 sh = *(const f32x4*)(shift + j * 256 + lane * 4);
                const f32x4 sc = *(const f32x4*)(scale + j * 256 + lane * 4);
                const f32x4 hv = (x[j] * rinv * gp) * (sc + 1.0f) + sh;
                *(u32x2*)(H + (size_t)row * 1024 + j * 256 + lane * 4) = pack4(hv);
            }
        }
    }
}

__device__ __forceinline__ int colmap(int mode, int n) {
    if (mode == 1) { const int G = n >> 5, w = n & 31; return w < 16 ? G * 16 + w : FH + G * 16 + (w - 16); }
    if (mode == 2) return n < 832 ? n : -1;
    if (mode == 3) { const int hh = (n & 1023) >> 7, d = n & 127; return hh * 256 + d + (n >= 1024 ? 128 : 0); }
    if (mode == 5) {
        if (n >= 1280) return n;
        const int head = n >> 7, cq = n & 127, q = cq >> 5, half = (cq >> 4) & 1, f16 = cq & 15;
        return head * 128 + (q >> 1) * 64 + half * 32 + (q & 1) * 16 + f16;
    }
    return n;
}
__device__ __forceinline__ void sincos_d(float ang, float& c, float& s) {
    const double a = (double)ang;
    const double k = rint(a * 0.63661977236758134308);
    const double r = a - k * 1.57079632679489661923;
    const double r2 = r * r;
    const double sp = r * (1.0 + r2 * (-1.0 / 6 + r2 * (1.0 / 120 + r2 * (-1.0 / 5040 + r2 * (1.0 / 362880 + r2 * (-1.0 / 39916800 + r2 * (1.0 / 6227020800.0)))))));
    const double cp = 1.0 + r2 * (-0.5 + r2 * (1.0 / 24 + r2 * (-1.0 / 720 + r2 * (1.0 / 40320 + r2 * (-1.0 / 3628800 + r2 * (1.0 / 479001600.0 + r2 * (-1.0 / 87178291200.0)))))));
    const int q = ((int)k) & 3;
    double cc, sn;
    if (q == 0) { cc = cp; sn = sp; } else if (q == 1) { cc = -sp; sn = cp; } else if (q == 2) { cc = -cp; sn = -sp; } else { cc = sp; sn = -cp; }
    c = (float)cc; s = (float)sn;
}

__device__ __forceinline__ void prologue_phase(const Params& p, char* smem) {
    const int tid = tid_();
    float* tile = (float*)smem;
#ifndef PRO_DUP
#define PRO_DUP 0
#endif
    for (int rep_ = 0; rep_ < (PRO_DUP == 2 ? 2 : 1); ++rep_)
    for (int task = blockIdx.x; task < 388; task += gridDim.x) {
        if (false) {
        } else if (task < 384) {
            const int mt = task, layer = mt / 96, n0 = (mt % 96) * 64;
            float* sl = (float*)smem;
            float* sx = sl + 1024;
            f32x4* red = (f32x4*)(sx + 1024);
            for (int k = tid; k < 1024; k += 512) { sl[k] = siluf_(p.in[1][k]); sx[k] = siluf_(p.in[3][k]); }
            __syncthreads();
            const int j4 = (tid & 15) * 4, kq = tid >> 4;
            const float* w = p.in[4] + (size_t)layer * 1024 * 6144 + n0 + j4;
            f32x4 al = (f32x4){0.f, 0.f, 0.f, 0.f}, ac = al;
#pragma unroll 16
            for (int k = kq * 32; k < kq * 32 + 32; ++k) { const f32x4 wv = __builtin_nontemporal_load((const f32x4*)(w + (size_t)k * 6144)); al += wv * sl[k]; ac += wv * sx[k]; }
            red[kq * 16 + (tid & 15)] = al; red[512 + kq * 16 + (tid & 15)] = ac;
            __syncthreads();
            if (tid < 32) {
                const int which = tid >> 4, jj = tid & 15;
                f32x4 sum = (f32x4){0.f, 0.f, 0.f, 0.f};
#pragma unroll 8
                for (int q = 0; q < 32; ++q) sum += red[which * 512 + q * 16 + jj];
                float* MOD = (float*)(p.ws + OFF_MOD);
                const f32x4 bb = *(const f32x4*)(p.in[5] + layer * 6144 + n0 + jj * 4);
                *(f32x4*)(MOD + (size_t)(layer * 2 + which) * 6144 + n0 + jj * 4) = sum + bb;
            }
            __syncthreads();
        } else {
            const int st = task - 384;
            if (st == 0) {
                float* cosT = (float*)(p.ws + OFF_ROPEA); float* sinT = cosT + 256 * 32;
                for (int e = tid; e < 256 * 32; e += 512) {
                    const int pos = e >> 5, f = e & 31;
                    const float pw = (float)pow(10000.0, (double)((float)(2 * f) / 64.0f));
                    const float inv = 1.0f / pw;
                    float c, s; sincos_d((float)pos * inv, c, s);
                    cosT[e] = c; sinT[e] = s;
                }
            } else if (st == 1) {
                float* cosT = (float*)(p.ws + OFF_ROPEC); float* sinT = cosT + 256 * 16;
                for (int e = tid; e < 256 * 16; e += 512) {
                    const int pos = e >> 4, f = e & 15;
                    const float pw = (float)pow(10000.0, (double)((float)(2 * f) / 32.0f));
                    const float inv = 1.0f / pw;
                    float c, s; sincos_d((float)pos * inv, c, s);
                    cosT[e] = c; sinT[e] = s;
                }
            } else if (st == 2) {
                float* gb = (float*)(p.ws + OFF_GBIAS);
                for (int n = tid; n < 4096; n += 512) {
                    const int dir = n >> 11, ch = (n & 2047) >> 1, gate = n & 1;
                    gb[n] = gate ? p.in[19][dir * 1024 + ch] : p.in[17][dir * 1024 + ch];
                }
            } else {
                float* ss = (float*)(p.ws + OFF_SS);
                for (int e = tid; e < NT * 2; e += 512) ss[e] = 0.f;
            }
        }
    }
    {
        constexpr int TS = 133;
        const int j4 = (tid & 31) * 4, kq = tid >> 5;
        const int jw = tid >> 4, kg = (tid & 15) * 8;
        f32x4 cur[2][8], nxt[2][8];
        ConvJob jb[2], jbn[2];
        int n0[2] = {0, 0}, k0[2] = {0, 0}, n0n[2] = {0, 0}, k0n[2] = {0, 0};
        auto locate = [&](int ct, ConvJob& J, int& N0, int& K0) __attribute__((always_inline)) {
            int ji = 0;
#pragma unroll 1
            for (int q = 1; q < NJOBS; ++q) if (ct >= p.jobs[q].tile0) ji = q;
            J = p.jobs[ji];
            const int lt = ct - J.tile0, tk = J.K >> 7;
            const int tni = lt / tk, tki = lt - tni * tk;
            N0 = tni * 128; K0 = tki * 128;
        };
        auto fetch = [&](const ConvJob& J, int N0, int K0, f32x4 (&v)[8]) __attribute__((always_inline)) {
            const int sc = colmap(J.mode, N0 + j4);
#pragma unroll
            for (int i = 0; i < 8; ++i) {
                const int kk = kq + 16 * i;
                v[i] = (f32x4){0.f, 0.f, 0.f, 0.f};
                if (sc >= 0) { v[i] = __builtin_nontemporal_load((const f32x4*)(J.src + (size_t)(K0 + kk) * J.ld + sc)); if (J.kscale) v[i] *= J.kscale[K0 + kk]; }
            }
        };
        const int G = gridDim.x, T = p.conv_tiles;
        int ct = blockIdx.x;
#pragma unroll
        for (int h = 0; h < 2; ++h) if (ct + h * G < T) { locate(ct + h * G, jb[h], n0[h], k0[h]); fetch(jb[h], n0[h], k0[h], cur[h]); }
        for (; ct < T; ct += 2 * G) {
#pragma unroll
            for (int h = 0; h < 2; ++h) if (ct + (2 + h) * G < T) { locate(ct + (2 + h) * G, jbn[h], n0n[h], k0n[h]); fetch(jbn[h], n0n[h], k0n[h], nxt[h]); }
#pragma unroll
            for (int h = 0; h < 2; ++h) {
                if (ct + h * G < T) {
#pragma unroll
                    for (int i = 0; i < 8; ++i) { float* tp = tile + (kq + 16 * i) * TS + j4; tp[0] = cur[h][i][0]; tp[1] = cur[h][i][1]; tp[2] = cur[h][i][2]; tp[3] = cur[h][i][3]; }
                    __syncthreads();
#pragma unroll
                    for (int ii = 0; ii < 4; ++ii) {
                        const int j = jw + 32 * ii;
                        float v[8];
#pragma unroll
                        for (int i = 0; i < 8; ++i) v[i] = tile[(kg + i) * TS + j];
                        u32x4 w; w.x = cvt_pk(v[0], v[1]); w.y = cvt_pk(v[2], v[3]); w.z = cvt_pk(v[4], v[5]); w.w = cvt_pk(v[6], v[7]);
                        *(u32x4*)(jb[h].dst + (size_t)(jb[h].roff + (n0[h] + j) * jb[h].rmul) * jb[h].K + k0[h] + kg) = w;
                    }
                    __syncthreads();
                }
            }
#pragma unroll
            for (int h = 0; h < 2; ++h) {
                jb[h] = jbn[h]; n0[h] = n0n[h]; k0[h] = k0n[h];
#pragma unroll
                for (int i = 0; i < 8; ++i) cur[h][i] = nxt[h][i];
            }
        }
    }
    __syncthreads();
}

__device__ __forceinline__ void conv_phase(const Params& p) {
    const bf16_t* ZX = (const bf16_t*)(p.ws + OFF_ZX);
    bf16_t* XB = (bf16_t*)(p.ws + OFF_H);
    const float* cw = p.in[13]; const float* cb = p.in[14];
    const int total = NT * 128;
    for (int e = blockIdx.x * 512 + tid_(); e < total; e += gridDim.x * 512) {
        const int row = e >> 7, c8 = (e & 127) * 8;
        const int seg_lo = row < NCTX ? 0 : NCTX, seg_hi = row < NCTX ? NCTX : NT;
        float acc[8];
#pragma unroll
        for (int i = 0; i < 8; ++i) acc[i] = cb[c8 + i];
#pragma unroll
        for (int k = 0; k < 4; ++k) {
            const int r = row + k - 1;
            if (r >= seg_lo && r < seg_hi) {
                const u32x4 z = *(const u32x4*)(ZX + (size_t)r * 1024 + c8);
                const f32x4 w0 = *(const f32x4*)(cw + k * 1024 + c8), w1 = *(const f32x4*)(cw + k * 1024 + c8 + 4);
                acc[0] += w0[0] * bflo(z.x); acc[1] += w0[1] * bfhi(z.x); acc[2] += w0[2] * bflo(z.y); acc[3] += w0[3] * bfhi(z.y);
                acc[4] += w1[0] * bflo(z.z); acc[5] += w1[1] * bfhi(z.z); acc[6] += w1[2] * bflo(z.w); acc[7] += w1[3] * bfhi(z.w);
            }
        }
        u32x4 o; o.x = cvt_pk(acc[0], acc[1]); o.y = cvt_pk(acc[2], acc[3]); o.z = cvt_pk(acc[4], acc[5]); o.w = cvt_pk(acc[6], acc[7]);
        *(u32x4*)(XB + (size_t)row * 1024 + c8) = o;
    }
}
__device__ __forceinline__ void scan_coef(unsigned ri, float u, float c8, float& a, float& b) {
    const float r = bflo(ri), i = bfhi(ri);
    const float la = -c8 * r;
    a = __expf(la);
    b = sqrtf(-expm1f(2.0f * la)) * (i * u);
}
__device__ __forceinline__ float lam_c8(const float* lam, int dir, int ch) {
    const float l = lam[dir * 1024 + ch];
    return 8.0f * (l > 0.f ? log1pf(__expf(-l)) : (-l + log1pf(__expf(l))));
}

__device__ __forceinline__ void scan1_phase(const Params& p) {
    const unsigned* GT = (const unsigned*)(p.ws + OFF_BIG + BB_GATES);
    const bf16_t* XB = (const bf16_t*)(p.ws + OFF_H);
    float* SA = (float*)(p.ws + OFF_SCAN); float* SB = SA + 2 * NRB * 1024;
    const int tid = tid_();
    for (int task = blockIdx.x; task < NRB * 2 * 2; task += gridDim.x) {
        const int rc = task >> 2, dir = (task >> 1) & 1, ch = (task & 1) * 512 + tid;
        const float c8 = lam_c8(p.in[15], dir, ch);
        float h = 0.f, P = 1.f;
#pragma unroll 8
        for (int s = 0; s < 128; ++s) {
            const int row = rc * 128 + (dir ? 127 - s : s);
            const unsigned ri = GT[(size_t)row * 2048 + dir * 1024 + ch];
            const float u = bf2f(XB[(size_t)row * 1024 + ch]);
            float a, b; scan_coef(ri, u, c8, a, b);
            h = a * h + b; P *= a;
        }
        SA[(size_t)(dir * NRB + rc) * 1024 + ch] = P;
        SB[(size_t)(dir * NRB + rc) * 1024 + ch] = h;
    }
}
__device__ __forceinline__ void scan3_phase(const Params& p) {
    unsigned* GT = (unsigned*)(p.ws + OFF_BIG + BB_GATES);
    const bf16_t* XB = (const bf16_t*)(p.ws + OFF_H);
    const bf16_t* G = (const bf16_t*)(p.ws + OFF_Y);
    bf16_t* HG = (bf16_t*)(p.ws + OFF_H);
    const float* SA = (const float*)(p.ws + OFF_SCAN); const float* SB = SA + 2 * NRB * 1024;
    const int tid = tid_();
    const int wv = tid >> 6, lane = tid & 63;
    for (int task = blockIdx.x * 8 + wv; task < NRB * 16; task += gridDim.x * 8) {
        const int rc = task >> 4, ch = (task & 15) * 64 + lane;
        {
            const float c8 = lam_c8(p.in[15], 0, ch);
            float h = 0.f;
#pragma unroll 8
            for (int j = 0; j < rc; ++j) h = SA[(size_t)j * 1024 + ch] * h + SB[(size_t)j * 1024 + ch];
#pragma unroll 8
            for (int s = 0; s < 128; ++s) {
                const int row = rc * 128 + s;
                const unsigned ri = GT[(size_t)row * 2048 + ch];
                const float u = bf2f(XB[(size_t)row * 1024 + ch]);
                float a, b; scan_coef(ri, u, c8, a, b);
                h = a * h + b;
                GT[(size_t)row * 2048 + ch] = __float_as_uint(h);
            }
        }
        {
            const float c8 = lam_c8(p.in[15], 1, ch);
            const float* SA1 = SA + (size_t)NRB * 1024; const float* SB1 = SB + (size_t)NRB * 1024;
            float h = 0.f;
            if (rc == 0) { h = SB1[(size_t)1 * 1024 + ch]; }
            else if (rc >= 2) {
                h = SB1[(size_t)1 * 1024 + ch];
                h = SA1[ch] * h + SB1[ch];
#pragma unroll 8
                for (int j = NRB - 1; j > rc; --j) h = SA1[(size_t)j * 1024 + ch] * h + SB1[(size_t)j * 1024 + ch];
            }
#pragma unroll 8
            for (int s = 0; s < 128; ++s) {
                const int row = rc * 128 + 127 - s;
                const unsigned ri = GT[(size_t)row * 2048 + 1024 + ch];
                const float u = bf2f(XB[(size_t)row * 1024 + ch]);
                float a, b; scan_coef(ri, u, c8, a, b);
                h = a * h + b;
                const float hf = __uint_as_float(GT[(size_t)row * 2048 + ch]);
                const float o = (hf + h) * bf2f(G[(size_t)row * 1024 + ch]);
                HG[(size_t)row * 1024 + ch] = (bf16_t)(cvt_pk(o, 0.f) & 0xffff);
            }
        }
    }
}

constexpr int NPHASES = 34;
__device__ __forceinline__ void ffn_gu(const Params& p, int l, char* smem) {
    EpiGU e{(bf16_t*)(p.ws + OFF_BIG)};
    gemm(smem, (const bf16_t*)(p.ws + OFF_H), 1024, (const bf16_t*)(p.ws + OFF_WB) + wo_gu(l), NT, 5632, 1024, 0, 0, e);
}
__device__ __forceinline__ void ffn_dn(const Params& p, int l, char* smem) {
    const bf16_t* A = (const bf16_t*)(p.ws + OFF_BIG); const bf16_t* W = (const bf16_t*)(p.ws + OFF_WB) + wo_dn(l);
    bf16_t* Y = (bf16_t*)(p.ws + OFF_Y);
    ctx_gemm_f32(smem, A, FH, W, FH, Y);
    EpiF32 e{Y + (size_t)NCTX * 1024, 1024};
    gemm<EpiF32, false>(smem, A + (size_t)NCTX * FH, FH, W, TL, 1024, FH, 0, 0, e);
}
__device__ __forceinline__ void proj_out(const Params& p, const bf16_t* A, size_t woff, char* smem) {
    const bf16_t* W = (const bf16_t*)(p.ws + OFF_WB) + woff;
    bf16_t* Y = (bf16_t*)(p.ws + OFF_Y);
    ctx_gemm_f32(smem, A, 1024, W, 1024, Y);
    EpiF32 e{Y + (size_t)NCTX * 1024, 1024};
    gemm<EpiF32, false>(smem, A + (size_t)NCTX * 1024, 1024, W, TL, 1024, 1024, 0, 0, e);
}
__device__ __forceinline__ void r1(const Params& p, int l) {
    const float* ng = p.in[6] + (size_t)l * 4 * 1024;
    rownorm_phase(p, 1, ng + 1024, 2, l, ng + 2048, 3, 4, l, l == 0);
}
__device__ __forceinline__ void r2(const Params& p, int l) {
    const float* ng = p.in[6] + (size_t)l * 4 * 1024;
    if (l < 3) rownorm_phase(p, 1, ng + 3072, 5, l, ng + 4096, 0, 1, l + 1);
    else rownorm_phase(p, 1, ng + 3072, 5, l, nullptr, 0, 0, 0);
}
__device__ __forceinline__ void layerA_qkv(const Params& p, int j, char* smem) {
    const bf16_t* H = (const bf16_t*)(p.ws + OFF_H);
    const bf16_t* W = (const bf16_t*)(p.ws + OFF_WB) + wo_aqkv(j);
    const float* cosT = (const float*)(p.ws + OFF_ROPEA);
    EpiQK e{(bf16_t*)(p.ws + OFF_BIG + BA_Q), (bf16_t*)(p.ws + OFF_BIG + BA_K), (bf16_t*)(p.ws + OFF_BIG + BA_VT), cosT, cosT + 256 * 32, 0.08838834764831845f * LOG2E};
    gemm(smem, H, 1024, W, NT, 1536, 1024, 0, 0, e);
}
__device__ __forceinline__ void layerA_attn(const Params& p, int j, char* smem) {
    attn_run<128, true>((const bf16_t*)(p.ws + OFF_BIG + BA_Q), 1024, (const bf16_t*)(p.ws + OFF_BIG + BA_K), 256, 4, nullptr,
                        (const bf16_t*)(p.ws + OFF_BIG + BA_VT), (bf16_t*)(p.ws + OFF_H), p.in[10] + j * 8, smem);
}

__device__ __forceinline__ void run_phase(const Params& p, int ph, char* smem) {
    const bf16_t* WB = (const bf16_t*)(p.ws + OFF_WB);
    const bf16_t* H = (const bf16_t*)(p.ws + OFF_H);
    switch (ph) {
    case 0: prologue_phase(p, smem); break;
    case 1: rownorm_phase(p, 0, nullptr, 0, 0, p.in[6], 0, 1, 0); break;
    case 2: layerA_qkv(p, 0, smem); break;
    case 3: layerA_attn(p, 0, smem); break;
    case 4: proj_out(p, H, wo_ao(0), smem); break;
    case 5: r1(p, 0); break;
    case 6: ffn_gu(p, 0, smem); break;
    case 7: ffn_dn(p, 0, smem); break;
    case 8: r2(p, 0); break;
    case 9: { EpiBin e{(bf16_t*)(p.ws + OFF_ZX), (bf16_t*)(p.ws + OFF_Y)}; gemm(smem, H, 1024, WB + WO_BIN, NT, 2048, 1024, 0, 0, e); } break;
    case 10: conv_phase(p); break;
    case 11: { EpiGates e{(bf16_t*)(p.ws + OFF_BIG + BB_GATES), (const float*)(p.ws + OFF_GBIAS)}; gemm(smem, H, 1024, WB + WO_BG, NT, 4096, 256, 1, 0, e); } break;
    case 12: scan1_phase(p); break;
    case 13: scan3_phase(p); break;
    case 14: proj_out(p, H, WO_BOUT, smem); break;
    case 15: r1(p, 1); break;
    case 16: ffn_gu(p, 1, smem); break;
    case 17: ffn_dn(p, 1, smem); break;
    case 18: r2(p, 1); break;
    case 19: { const float* cosT = (const float*)(p.ws + OFF_ROPEC);
               EpiCin e{(bf16_t*)(p.ws + OFF_ZQ), (bf16_t*)(p.ws + OFF_ZKV), (bf16_t*)(p.ws + OFF_KR), (float*)(p.ws + OFF_SS), cosT, cosT + 256 * 16};
               gemm(smem, H, 1024, WB + WO_CIN, NT, 1024, 1024, 0, 0, e); } break;
    case 20: { const float* cosT = (const float*)(p.ws + OFF_ROPEC); const float* ss = (const float*)(p.ws + OFF_SS);
               const bf16_t* ZQ = (const bf16_t*)(p.ws + OFF_ZQ); const bf16_t* ZKV = (const bf16_t*)(p.ws + OFF_ZKV);
               EpiQc eq{(bf16_t*)(p.ws + OFF_BIG + BC_QC), ss, cosT, cosT + 256 * 16, 0.07216878364870322f * LOG2E};
               gemm(smem, ZQ, 512, WB + WO_CUQ, NT, 1536, 512, 0, 0, eq);
               EpiKn ek{(bf16_t*)(p.ws + OFF_BIG + BC_KN), ss};
               gemm(smem, ZKV, 256, WB + WO_CUKV, NT, 1024, 256, 0, 390 % 256, ek);
               EpiVT ev{(bf16_t*)(p.ws + OFF_BIG + BC_VT), ss, 1, 1.0f / 256.0f};
               gemm(smem, WB + WO_CUKV + (size_t)1024 * 256, 256, ZKV, 1024, NT, 256, 0, (390 + 260) % 256, ev); } break;
    case 21: attn_run<192, false>((const bf16_t*)(p.ws + OFF_BIG + BC_QC), 1536, (const bf16_t*)(p.ws + OFF_BIG + BC_KN), 1024, 1,
                                  (const bf16_t*)(p.ws + OFF_KR), (const bf16_t*)(p.ws + OFF_BIG + BC_VT), (bf16_t*)(p.ws + OFF_H), nullptr, smem); break;
    case 22: proj_out(p, H, WO_COUT, smem); break;
    case 23: r1(p, 2); break;
    case 24: ffn_gu(p, 2, smem); break;
    case 25: ffn_dn(p, 2, smem); break;
    case 26: r2(p, 2); break;
    case 27: layerA_qkv(p, 1, smem); break;
    case 28: layerA_attn(p, 1, smem); break;
    case 29: proj_out(p, H, wo_ao(1), smem); break;
    case 30: r1(p, 3); break;
    case 31: ffn_gu(p, 3, smem); break;
    case 32: ffn_dn(p, 3, smem); break;
    case 33: r2(p, 3); break;
    default: break;
    }
}

#define XB_TMO      128
#define XB_XCNT(j)  (256  + 64 * (j))
#define XB_XSUB(j)  (1280 + 64 * (j))
#define XB_XGEN(j)  (2304 + 64 * (j))
#define XB_TOP      3328
#define XB_TOPGEN   3392
#define XCD_BAR_WORDS 3456
#define XB_SPIN_CAP (1u << 20)
#define LAS __attribute__((address_space(3)))
__device__ __forceinline__ unsigned xb_ld(unsigned* p)              { return __hip_atomic_load(p, __ATOMIC_RELAXED, __HIP_MEMORY_SCOPE_AGENT); }
__device__ __forceinline__ unsigned xb_add(unsigned* p, unsigned v) { return __hip_atomic_fetch_add(p, v, __ATOMIC_RELAXED, __HIP_MEMORY_SCOPE_AGENT); }
__device__ __forceinline__ unsigned xb_xcc_id() { return (unsigned)__builtin_amdgcn_s_getreg((3 << 11) | 20) & 0xFu; }
#define XB_SPIN(cond, bar) do { unsigned _sp = 0; while (cond) { __builtin_amdgcn_s_sleep(1); \
    if ((++_sp & 255u) == 0u) { if (xb_ld(&(bar)[XB_TMO])) break; if (_sp > XB_SPIN_CAP) { atomicAdd(&(bar)[XB_TMO], 1u); break; } } } } while (0)
struct XcdBarrier { unsigned* bar; unsigned x; volatile LAS unsigned* st; };
__device__ __forceinline__ XcdBarrier xcd_barrier_post(unsigned* bar, volatile LAS unsigned* st) {
    XcdBarrier b; b.bar = bar; b.x = xb_xcc_id(); b.st = st;
    if (threadIdx.x == 0) (void)xb_add(&bar[XB_XCNT(b.x)], 1u);
    return b;
}
__device__ __forceinline__ void xcd_barrier_complete(unsigned* bar, unsigned x, unsigned& nloc, unsigned& nx) {
    const unsigned G = gridDim.x * gridDim.y * gridDim.z;
    unsigned sum, cnt, mine, sp = 0u;
    for (;;) {
        sum = 0u; cnt = 0u; mine = 0u;
#pragma unroll
        for (unsigned j = 0; j < 16; ++j) { const unsigned c = xb_ld(&bar[XB_XCNT(j)]); sum += c; cnt += (c > 0u) ? 1u : 0u; mine = (j == x) ? c : mine; }
        if (sum == G) break;
        __builtin_amdgcn_s_sleep(1);
        if ((++sp & 255u) == 0u) { if (xb_ld(&bar[XB_TMO])) break; if (sp > XB_SPIN_CAP) { atomicAdd(&bar[XB_TMO], 1u); break; } }
    }
    nloc = mine > 0u ? mine : 1u; nx = cnt > 0u ? cnt : 1u;
}
__device__ __forceinline__ void xcd_barrier(const XcdBarrier& b) {
    asm volatile("s_waitcnt vmcnt(0)" ::: "memory");
    __syncthreads();
    if (threadIdx.x == 0) {
        unsigned* bar = b.bar;
        __builtin_amdgcn_s_waitcnt(0);
        unsigned nloc = b.st[0], nx = b.st[1];
        if (nloc == 0u) { xcd_barrier_complete(bar, b.x, nloc, nx); b.st[0] = nloc; b.st[1] = nx; }
        const unsigned old = xb_add(&bar[XB_XSUB(b.x)], 1u);
        const unsigned gen = old / nloc;
        if (old + 1u == (gen + 1u) * nloc) {
            __builtin_amdgcn_fence(__ATOMIC_RELEASE, "agent");
            asm volatile("s_waitcnt vmcnt(0)" ::: "memory");
            const unsigned og = xb_add(&bar[XB_TOP], 1u);
            const unsigned tg = og / nx;
            if (og + 1u == (tg + 1u) * nx) xb_add(&bar[XB_TOPGEN], 1u);
            else XB_SPIN(xb_ld(&bar[XB_TOPGEN]) == tg, bar);
            __builtin_amdgcn_fence(__ATOMIC_ACQUIRE, "agent");
            xb_add(&bar[XB_XGEN(b.x)], 1u);
            asm volatile("s_waitcnt vmcnt(0)" ::: "memory");
        } else {
            XB_SPIN(xb_ld(&bar[XB_XGEN(b.x)]) == gen, bar);
            __builtin_amdgcn_fence(__ATOMIC_ACQUIRE, "agent");
            asm volatile("s_waitcnt vmcnt(0)" ::: "memory");
        }
    }
    __syncthreads();
}

#ifndef DUP_SET
#define DUP_SET 0
#endif
__host__ __device__ constexpr bool dup_phase(int ph) {
    if (DUP_SET == 1) return ph == 2 || ph == 4 || ph == 6 || ph == 7 || ph == 9 || ph == 11 || ph == 14 || ph == 16 || ph == 17 || ph == 20 || ph == 22 || ph == 24 || ph == 25 || ph == 27 || ph == 29 || ph == 31 || ph == 32;
    if (DUP_SET == 2) return ph == 21;
    if (DUP_SET == 4) return ph == 4 || ph == 7 || ph == 14 || ph == 17 || ph == 22 || ph == 25 || ph == 29 || ph == 32;
    if (DUP_SET == 5) return ph == 0;
    if (DUP_SET == 6) return ph == 6 || ph == 16 || ph == 24 || ph == 31;
    if (DUP_SET == 3) return ph == 3 || ph == 28 || ph == 10 || ph == 12;
    return false;
}
template <int PH>
__device__ __forceinline__ void run_all(const Params& p, char* smem, const XcdBarrier& xb) {
    if constexpr (PH < NPHASES) {
        if constexpr (dup_phase(PH)) { run_phase(p, PH, smem); xcd_barrier(xb); }
#ifdef ONLY_LO
        if constexpr (PH >= ONLY_LO && PH <= ONLY_HI)
#endif
        run_phase(p, PH, smem);
        if constexpr (PH + 1 < NPHASES) {
            xcd_barrier(xb);
        }
        run_all<PH + 1>(p, smem, xb);
    }
}
constexpr int LDS_PHASE = 131072;
constexpr int DYN_LDS = LDS_PHASE + 16;
__global__ void __launch_bounds__(512, 2) mega(const Params p) {
    extern __shared__ __attribute__((aligned(16))) char smem[];
    volatile LAS unsigned* st = (volatile LAS unsigned*)(smem + LDS_PHASE);
    if (threadIdx.x < 4) st[threadIdx.x] = 0u;
    __syncthreads();
    const XcdBarrier xb = xcd_barrier_post((unsigned*)(p.ws + OFF_BAR), st);
    if (p.pad != 0) cg::this_grid().sync();
    run_all<0>(p, smem, xb);
}

static void add_job(Params& P, int& nj, int& tiles, const float* src, bf16_t* dst, const float* kscale, int K, int N, int ld, int mode, int rmul, int roff) {
    ConvJob& j = P.jobs[nj++];
    j.src = src; j.dst = dst; j.kscale = kscale; j.K = K; j.N = N; j.ld = ld; j.mode = mode; j.rmul = rmul; j.roff = roff; j.tile0 = tiles; j.pad = 0;
    tiles += (K / 128) * (N / 128);
}

extern "C" void kernel_launch(void* const* d_in, const int* in_sizes, int n_in, void* d_out, int out_size, void* d_ws, size_t ws_size, hipStream_t stream) {
    if (n_in != 27 || ws_size < WS_NEED || out_size != TL * DM) { (void)hipMemsetAsync(d_out, 0, (size_t)out_size * 4, stream); fprintf(stderr, "kernel_launch: unexpected sizes (n_in %d ws %zu need %zu out %d)\n", n_in, ws_size, (size_t)WS_NEED, out_size); return; }
    Params P;
    memset(&P, 0, sizeof(P));
    for (int i = 0; i < 27; ++i) P.in[i] = (const float*)d_in[i];
    P.out = (float*)d_out;
    P.ws = (char*)d_ws;
    bf16_t* WB = (bf16_t*)((char*)d_ws + OFF_WB);
    int nj = 0, tiles = 0;
    for (int l = 0; l < 4; ++l) {
        add_job(P, nj, tiles, P.in[7] + (size_t)l * 1024 * 5632, WB + wo_gu(l), nullptr, 1024, 5632, 5632, 1, 1, 0);
        add_job(P, nj, tiles, P.in[8] + (size_t)l * FH * 1024, WB + wo_dn(l), nullptr, FH, 1024, 1024, 0, 1, 0);
    }
    for (int j = 0; j < 2; ++j) {
        add_job(P, nj, tiles, P.in[9] + (size_t)j * 1024 * 1536, WB + wo_aqkv(j), nullptr, 1024, 1536, 1536, 5, 1, 0);
        add_job(P, nj, tiles, P.in[11] + (size_t)j * 1024 * 1024, WB + wo_ao(j), nullptr, 1024, 1024, 1024, 0, 1, 0);
    }
    add_job(P, nj, tiles, P.in[12], WB + WO_BIN, nullptr, 1024, 2048, 2048, 0, 1, 0);
    for (int dir = 0; dir < 2; ++dir)
        for (int blk = 0; blk < 4; ++blk) {
            add_job(P, nj, tiles, P.in[16] + (size_t)(dir * 4 + blk) * 65536, WB + WO_BG, nullptr, 256, 256, 256, 0, 2, dir * 2048 + blk * 512 + 0);
            add_job(P, nj, tiles, P.in[18] + (size_t)(dir * 4 + blk) * 65536, WB + WO_BG, nullptr, 256, 256, 256, 0, 2, dir * 2048 + blk * 512 + 1);
        }
    add_job(P, nj, tiles, P.in[20], WB + WO_BOUT, nullptr, 1024, 1024, 1024, 0, 1, 0);
    add_job(P, nj, tiles, P.in[21], WB + WO_CIN, nullptr, 1024, 1024, 832, 2, 1, 0);
    add_job(P, nj, tiles, P.in[24], WB + WO_CUQ, P.in[22], 512, 1536, 1536, 0, 1, 0);
    add_job(P, nj, tiles, P.in[25], WB + WO_CUKV, P.in[23], 256, 2048, 2048, 3, 1, 0);
    add_job(P, nj, tiles, P.in[26], WB + WO_COUT, nullptr, 1024, 1024, 1024, 0, 1, 0);
    P.conv_tiles = tiles;
    if (nj != NJOBS) { fprintf(stderr, "job count %d\n", nj); return; }

    static int grid_blocks = 0;
    if (!grid_blocks) {
        int dev = 0, cus = 0, per_cu = 0;
        (void)hipGetDevice(&dev);
        (void)hipDeviceGetAttribute(&cus, hipDeviceAttributeMultiprocessorCount, dev);
        (void)hipFuncSetAttribute((const void*)mega, hipFuncAttributeMaxDynamicSharedMemorySize, DYN_LDS);
        (void)hipOccupancyMaxActiveBlocksPerMultiprocessor(&per_cu, mega, 512, DYN_LDS);
        if (per_cu > 1) per_cu = 1;
        if (per_cu < 1) per_cu = 1;
        grid_blocks = cus * per_cu;
    }
    (void)hipMemsetAsync((char*)d_ws + OFF_BAR, 0, 16384, stream);
    void* args[] = {(void*)&P};
    hipError_t e = hipLaunchCooperativeKernel((void*)mega, dim3(grid_blocks), dim3(512), args, DYN_LDS, stream);
    if (e != hipSuccess) fprintf(stderr, "cooperative launch failed: %s (grid %d)\n", hipGetErrorString(e), grid_blocks);
}
```
